# Optimizing an MI355X kernel written in HIP

```python
import math
import jax, jax.numpy as jnp
from jax import lax
import numpy as np

D_MODEL = 1024
BATCH = 4
SEQ = 8192
DEPTH = 2

N_EVEN = (DEPTH + 1) // 2
N_ODD = DEPTH // 2

POOL_WIDTH = D_MODEL // 2
POOL_WINDOWS = (2, 4, 8, 16)
N_POOL_GROUPS = len(POOL_WINDOWS)
POOL_GROUP = POOL_WIDTH // N_POOL_GROUPS

ATTN_WIDTH = D_MODEL - POOL_WIDTH
DA_HEAD_V = 128
DA_HEADS = ATTN_WIDTH // DA_HEAD_V
DA_HEAD_QK = DA_HEAD_V // 2
ROT_DIM = DA_HEAD_QK // 4
ROPE_THETA = 500000.0
Q_BLOCK = 128

IN_WIDTH = POOL_WIDTH + 3 * ATTN_WIDTH

CONV_WIDTH = D_MODEL
CONV_KERNEL = 31

D_FF = 4 * D_MODEL

RMS_EPS = 1e-6
LN_EPS = 1e-5
SUBLN_EPS = 1e-5

kernel_name = "hybrid_pool_diffattn_conformer_trunk"


def rmsnorm(x, g, eps=RMS_EPS):
    xf = x.astype(jnp.float32)
    y = xf * lax.rsqrt(jnp.mean(xf * xf, axis=-1, keepdims=True) + eps)
    return (y * g.astype(jnp.float32)).astype(x.dtype)


def layernorm(x, g, b, eps=LN_EPS):
    xf = x.astype(jnp.float32)
    mu = jnp.mean(xf, axis=-1, keepdims=True)
    var = jnp.mean(jnp.square(xf - mu), axis=-1, keepdims=True)
    y = (xf - mu) * lax.rsqrt(var + eps)
    return (y * g.astype(jnp.float32) + b.astype(jnp.float32)).astype(x.dtype)


def rope_tables(S):
    pos = jnp.arange(S, dtype=jnp.float32)
    inv_freq = ROPE_THETA ** (-jnp.arange(0, ROT_DIM, 2, dtype=jnp.float32) / ROT_DIM)
    ang = pos[:, None] * inv_freq[None, :]
    return jnp.cos(ang), jnp.sin(ang)


def rope_partial(x, cos, sin):
    half = ROT_DIM // 2
    xr = x[..., :ROT_DIM].astype(jnp.float32)
    x1, x2 = xr[..., :half], xr[..., half:]
    c = cos[None, :, None, None, :]
    s = sin[None, :, None, None, :]
    rot = jnp.concatenate([x1 * c - x2 * s, x2 * c + x1 * s], axis=-1).astype(x.dtype)
    return jnp.concatenate([rot, x[..., ROT_DIM:]], axis=-1)


def multiscale_pool(u):
    B, S, _ = u.shape
    uf = u.astype(jnp.float32).reshape(B, S, N_POOL_GROUPS, POOL_GROUP)
    cs = jnp.cumsum(uf, axis=1)
    t = jnp.arange(S)
    outs = []
    for g, w in enumerate(POOL_WINDOWS):
        c = cs[:, :, g]
        prev = jnp.pad(c, ((0, 0), (w, 0), (0, 0)))[:, :S]
        cnt = jnp.minimum(t + 1, w).astype(jnp.float32)[None, :, None]
        outs.append((c - prev) / cnt - uf[:, :, g])
    return jnp.stack(outs, axis=2).astype(u.dtype)


def diff_attention(q, k, v, lam):
    B, S = q.shape[:2]
    nb = S // Q_BLOCK
    scale = DA_HEAD_QK ** -0.5
    qb = q.reshape(B, nb, Q_BLOCK, DA_HEADS, 2, DA_HEAD_QK).transpose(1, 0, 2, 3, 4, 5)
    k_pos = jnp.arange(S)

    def one_block(args):
        i, qi = args
        s = jnp.einsum('bqhcd,bkhcd->bhcqk', qi, k,
                       preferred_element_type=jnp.float32) * scale
        q_pos = i * Q_BLOCK + jnp.arange(Q_BLOCK)
        mask = k_pos[None, :] <= q_pos[:, None]
        s = jnp.where(mask, s, -jnp.inf)
        p = jax.nn.softmax(s, axis=-1)
        w = p[:, :, 0] - lam * p[:, :, 1]
        return jnp.einsum('bhqk,bkhe->bqhe', w.astype(v.dtype), v)

    out = lax.map(one_block, (jnp.arange(nb), qb))
    return out.transpose(1, 0, 2, 3, 4).reshape(B, S, DA_HEADS, DA_HEAD_V)


def pool_diff_mixer(h, layer_idx, cos, sin, w_in, pool_w, pool_scale,
                    lam_q1, lam_k1, lam_q2, lam_k2, subln, w_out):
    B, S, _ = h.shape
    z = h @ w_in
    u = z[..., :POOL_WIDTH]
    q = z[..., POOL_WIDTH:POOL_WIDTH + ATTN_WIDTH].reshape(B, S, DA_HEADS, 2, DA_HEAD_QK)
    k = z[..., POOL_WIDTH + ATTN_WIDTH:POOL_WIDTH + 2 * ATTN_WIDTH].reshape(
        B, S, DA_HEADS, 2, DA_HEAD_QK)
    v = z[..., POOL_WIDTH + 2 * ATTN_WIDTH:].reshape(B, S, DA_HEADS, DA_HEAD_V)

    pooled = multiscale_pool(u)
    a_out = jnp.einsum('bsgc,gcd->bsgd', pooled, pool_w).reshape(B, S, POOL_WIDTH)
    a_out = a_out * pool_scale

    q = rope_partial(q, cos, sin)
    k = rope_partial(k, cos, sin)
    lambda_init = 0.8 - 0.6 * math.exp(-0.3 * layer_idx)
    lam = (jnp.exp(jnp.sum(lam_q1.astype(jnp.float32) * lam_k1.astype(jnp.float32)))
           - jnp.exp(jnp.sum(lam_q2.astype(jnp.float32) * lam_k2.astype(jnp.float32)))
           + lambda_init)
    o = diff_attention(q, k, v, lam)
    o = rmsnorm(o, subln, SUBLN_EPS) * (1.0 - lambda_init)
    b_out = o.reshape(B, S, ATTN_WIDTH)

    return jnp.concatenate([a_out, b_out.astype(a_out.dtype)], axis=-1) @ w_out


def conformer_conv(h, pw1_w, pw1_b, dw_w, dw_b, ln_g, ln_b, pw2_w, pw2_b):
    a = h @ pw1_w + pw1_b
    g = a[..., :CONV_WIDTH] * jax.nn.sigmoid(a[..., CONV_WIDTH:])
    y = lax.conv_general_dilated(
        g, dw_w[:, None, :].astype(g.dtype), window_strides=(1,),
        padding=((CONV_KERNEL - 1, 0),),
        dimension_numbers=('NWC', 'WIO', 'NWC'),
        feature_group_count=CONV_WIDTH) + dw_b
    y = jax.nn.silu(layernorm(y, ln_g, ln_b))
    return y @ pw2_w + pw2_b


def sq_relu_mlp(h, w_up, w_down):
    return jnp.square(jax.nn.relu(h @ w_up)) @ w_down


def setup_inputs(seed: int = 0) -> dict:
    key = jax.random.key(seed)
    ks = iter(jax.random.split(key, 32))

    def nrm(shape, scale):
        return jax.random.normal(next(ks), shape, jnp.float32) * scale

    def gain(shape):
        return 1.0 + nrm(shape, 0.05)

    return {
        "x": nrm((BATCH, SEQ, D_MODEL), 1.0),
        "mix_norm": gain((DEPTH, D_MODEL)),
        "mlp_norm": gain((DEPTH, D_MODEL)),
        "w_up": nrm((DEPTH, D_MODEL, D_FF), D_MODEL ** -0.5),
        "w_down": nrm((DEPTH, D_FF, D_MODEL), D_FF ** -0.5),
        "final_norm": gain((D_MODEL,)),
        "w_in": nrm((N_EVEN, D_MODEL, IN_WIDTH), D_MODEL ** -0.5),
        "pool_w": nrm((N_EVEN, N_POOL_GROUPS, POOL_GROUP, POOL_GROUP), POOL_GROUP ** -0.5),
        "pool_scale": gain((N_EVEN, POOL_WIDTH)),
        "lam_q1": nrm((N_EVEN, DA_HEAD_QK), 0.1),
        "lam_k1": nrm((N_EVEN, DA_HEAD_QK), 0.1),
        "lam_q2": nrm((N_EVEN, DA_HEAD_QK), 0.1),
        "lam_k2": nrm((N_EVEN, DA_HEAD_QK), 0.1),
        "subln": gain((N_EVEN, DA_HEAD_V)),
        "w_out": nrm((N_EVEN, D_MODEL, D_MODEL), D_MODEL ** -0.5),
        "conv_pw1_w": nrm((N_ODD, D_MODEL, 2 * CONV_WIDTH), D_MODEL ** -0.5),
        "conv_pw1_b": nrm((N_ODD, 2 * CONV_WIDTH), 0.02),
        "conv_dw_w": nrm((N_ODD, CONV_KERNEL, CONV_WIDTH), CONV_KERNEL ** -0.5),
        "conv_dw_b": nrm((N_ODD, CONV_WIDTH), 0.02),
        "conv_ln_g": gain((N_ODD, CONV_WIDTH)),
        "conv_ln_b": nrm((N_ODD, CONV_WIDTH), 0.02),
        "conv_pw2_w": nrm((N_ODD, CONV_WIDTH, D_MODEL), CONV_WIDTH ** -0.5),
        "conv_pw2_b": nrm((N_ODD, D_MODEL), 0.02),
    }


def reference(x, mix_norm, mlp_norm, w_up, w_down, final_norm,
              w_in, pool_w, pool_scale, lam_q1, lam_k1, lam_q2, lam_k2, subln, w_out,
              conv_pw1_w, conv_pw1_b, conv_dw_w, conv_dw_b, conv_ln_g, conv_ln_b,
              conv_pw2_w, conv_pw2_b):
    S = x.shape[1]
    cos, sin = rope_tables(S)
    h = x
    for l in range(DEPTH):
        j = l // 2
        hn = rmsnorm(h, mix_norm[l])
        if l % 2 == 0:
            mix = pool_diff_mixer(hn, l, cos, sin, w_in[j], pool_w[j], pool_scale[j],
                                  lam_q1[j], lam_k1[j], lam_q2[j], lam_k2[j],
                                  subln[j], w_out[j])
        else:
            mix = conformer_conv(hn, conv_pw1_w[j], conv_pw1_b[j], conv_dw_w[j],
                                 conv_dw_b[j], conv_ln_g[j], conv_ln_b[j],
                                 conv_pw2_w[j], conv_pw2_b[j])
        h = h + mix.astype(h.dtype)
        h = h + sq_relu_mlp(rmsnorm(h, mlp_norm[l]), w_up[l], w_down[l]).astype(h.dtype)
    return rmsnorm(h, final_norm)
```

```cpp
#include <hip/hip_runtime.h>
#include <hip/hip_cooperative_groups.h>
#include <cstdio>
#include <cstdint>
#include <cmath>
namespace cg = cooperative_groups;

__device__ __forceinline__ int opaque_tid() { int t = threadIdx.x; asm volatile("" : "+v"(t)); return t; }

namespace pg8 {
#define PG8_LAS __attribute__((address_space(3)))
typedef unsigned short bf16_t;
typedef short bf16x8 __attribute__((ext_vector_type(8)));
typedef float f32x4 __attribute__((ext_vector_type(4)));
typedef unsigned u32x4 __attribute__((ext_vector_type(4)));
constexpr int BM = 256, BK = 64, HALF = 128, HTB = HALF * BK * 2  , STAGE_BYTES = 8 * HTB, NXCD = 8, WGM = 8;

__host__ __device__ __forceinline__ int lds_byte(int r, int c) { const int st = (r >> 4) * 2 + (c >> 5), rr = r & 15, cc = c & 31, ob = rr * 64 + cc * 2; return st * 1024 + (ob ^ (((ob >> 9) & 1) << 5)); }
__host__ __device__ __forceinline__ void stage_rc(int b, int& R, int& C) { const int st = b / 1024, sb = b % 1024, swz = sb ^ (((sb >> 9) & 1) << 5); R = (st >> 1) * 16 + swz / 64; C = (st & 1) * 32 + (swz % 64) / 2; }
__host__ __device__ __forceinline__ int perm32(int rho) { const int n = rho >> 4, i = rho & 15; return 8 * (i >> 2) + 4 * n + (i & 3); }

struct Unit { int pm, pn; };
struct Gemm { const bf16_t* A; const bf16_t* Bt; int M, N, K; };

struct StaticOrder {
    int nM, nN, nwg, G, c;
    __host__ __device__ void init(int M, int N, int G_, int c_) { nM = M / BM; nN = N / BM; nwg = nM * nN; G = G_; c = c_; }
    __host__ __device__ bool next(int i, Unit& u) const {
        const long L = (long)i * G + c; if (L >= nwg) return false;
        int wgid = (int)L; { const int q = nwg / NXCD, r = nwg % NXCD, xcd = wgid % NXCD, off = wgid / NXCD; wgid = (xcd < r ? xcd * (q + 1) : r * (q + 1) + (xcd - r) * q) + off; }
        const int nig = WGM * nN, gid = wgid / nig, fm = gid * WGM, gsz = (nM - fm) < WGM ? (nM - fm) : WGM;
        u.pm = fm + ((wgid % nig) % gsz); u.pn = (wgid % nig) / gsz; return true;
    }
    __device__ __forceinline__ void a_ready(const Unit&) const {}
    __device__ __forceinline__ void done(const Unit&) const {}
};

typedef float f32x2v __attribute__((ext_vector_type(2))); typedef __bf16 bf16x2v __attribute__((ext_vector_type(2)));
__device__ __forceinline__ unsigned cvt_pk_bf16(float lo, float hi) { f32x2v v = {lo, hi}; bf16x2v b = __builtin_convertvector(v, bf16x2v); return __builtin_bit_cast(unsigned, b); }
__device__ __forceinline__ u32x4 pack8(const f32x4& v0, const f32x4& v1) { u32x4 w; w.x = cvt_pk_bf16(v0[0], v0[1]); w.y = cvt_pk_bf16(v0[2], v0[3]); w.z = cvt_pk_bf16(v1[0], v1[1]); w.w = cvt_pk_bf16(v1[2], v1[3]); return w; }

constexpr int MROWS = 32768;
constexpr float C2 = 0.125f * 1.4426950408889634f;
constexpr float RMS_EPS = 1e-6f;

__device__ __forceinline__ float row_inv_rms(const float* ssp, int row) {
    const f32x4* p = (const f32x4*)(ssp + (size_t)row * 16);
    const f32x4 a = p[0], b = p[1], c = p[2], d = p[3];
    const float s = ((a[0] + a[1]) + (a[2] + a[3])) + ((b[0] + b[1]) + (b[2] + b[3])) + ((c[0] + c[1]) + (c[2] + c[3])) + ((d[0] + d[1]) + (d[2] + d[3]));
    return 1.0f / sqrtf(s * (1.0f / 1024.0f) + RMS_EPS);
}

struct EpiIn {
    static constexpr bool PERM = true, AFTER_DRAIN = false;
    bf16_t* Z; const float* rope;
    __device__ __forceinline__ void operator()(const f32x4 (&acc)[2][2][4][2], const Unit& u, int wr, int wc, int fr, int fq) const {
        const int sec = u.pn >> 1;
        bf16_t* base = Z + (size_t)sec * MROWS * 512;
        const int cs0 = (u.pn & 1) * 256 + wc * 32 + 8 * fq;
        const int row0 = u.pm * BM + wr * 64 + fr;
        const bool ropew = (sec == 1 || sec == 2) && ((wc & 1) == 0);
        const float sc = (sec == 1) ? C2 : 1.0f;
#pragma unroll
        for (int ai = 0; ai < 2; ++ai)
#pragma unroll
            for (int m = 0; m < 4; ++m) {
                const int row = row0 + ai * HALF + m * 16; const int pos = row & 8191;
                f32x4 c0 = {1.f, 1.f, 1.f, 1.f}, c1 = c0, s0 = {0.f, 0.f, 0.f, 0.f}, s1 = s0;
                if (ropew) { const f32x4* cp = (const f32x4*)(rope + (size_t)pos * 8); const f32x4* sp = (const f32x4*)(rope + 65536 + (size_t)pos * 8); c0 = cp[0]; c1 = cp[1]; s0 = sp[0]; s1 = sp[1]; }
#pragma unroll
                for (int bj = 0; bj < 2; ++bj) {
                    f32x4 v0 = acc[ai][bj][m][0], v1 = acc[ai][bj][m][1];
                    if (ropew) {
                        f32x4 p0, p1;
#pragma unroll
                        for (int e = 0; e < 4; ++e) { p0[e] = __shfl_xor(v0[e], 16); p1[e] = __shfl_xor(v1[e], 16); }
                        if (fq == 0) { v0 = v0 * c0 - p0 * s0; v1 = v1 * c1 - p1 * s1; }
                        else if (fq == 1) { v0 = v0 * c0 + p0 * s0; v1 = v1 * c1 + p1 * s1; }
                    }
                    v0 = v0 * sc; v1 = v1 * sc;
                    *(u32x4*)(base + (size_t)row * 512 + cs0 + bj * HALF) = pack8(v0, v1);
                }
            }
    }
};

struct EpiRes {
    static constexpr bool PERM = true, AFTER_DRAIN = false;
    const float* R; float* H; bf16_t* HB; const float* bias; float* ssp;
    __device__ __forceinline__ void operator()(const f32x4 (&acc)[2][2][4][2], const Unit& u, int wr, int wc, int fr, int fq) const {
        const int row0 = u.pm * BM + wr * 64 + fr, col0 = u.pn * BM + wc * 32 + 8 * fq;
        f32x4 bv[2][2];
#pragma unroll
        for (int bj = 0; bj < 2; ++bj)
#pragma unroll
            for (int n = 0; n < 2; ++n) bv[bj][n] = bias ? *(const f32x4*)(bias + col0 + bj * HALF + 4 * n) : (f32x4){0.f, 0.f, 0.f, 0.f};
#pragma unroll
        for (int ai = 0; ai < 2; ++ai)
#pragma unroll
            for (int m = 0; m < 4; ++m) {
                const int row = row0 + ai * HALF + m * 16; float ss = 0.f;
#pragma unroll
                for (int bj = 0; bj < 2; ++bj) {
                    const size_t off = (size_t)row * 1024 + col0 + bj * HALF;
                    const f32x4 r0 = *(const f32x4*)(R + off), r1 = *(const f32x4*)(R + off + 4);
                    const f32x4 v0 = acc[ai][bj][m][0] + bv[bj][0] + r0, v1 = acc[ai][bj][m][1] + bv[bj][1] + r1;
                    *(f32x4*)(H + off) = v0; *(f32x4*)(H + off + 4) = v1;
                    *(u32x4*)(HB + off) = pack8(v0, v1);
                    ss += (v0[0] * v0[0] + v0[1] * v0[1]) + (v0[2] * v0[2] + v0[3] * v0[3]) + (v1[0] * v1[0] + v1[1] * v1[1]) + (v1[2] * v1[2] + v1[3] * v1[3]);
                }
                ss += __shfl_xor(ss, 16); ss += __shfl_xor(ss, 32);
                if (fq == 0) ssp[(size_t)row * 16 + u.pn * 4 + wc] = ss;
                asm volatile("" ::: "memory");
            }
    }
};

struct EpiUp {
    static constexpr bool PERM = true, AFTER_DRAIN = false;
    bf16_t* O; const float* ssp;
    __device__ __forceinline__ void operator()(const f32x4 (&acc)[2][2][4][2], const Unit& u, int wr, int wc, int fr, int fq) const {
        const int row0 = u.pm * BM + wr * 64 + fr, col0 = u.pn * BM + wc * 32 + 8 * fq;
#pragma unroll
        for (int ai = 0; ai < 2; ++ai)
#pragma unroll
            for (int m = 0; m < 4; ++m) {
                const int row = row0 + ai * HALF + m * 16; const float s = row_inv_rms(ssp, row);
#pragma unroll
                for (int bj = 0; bj < 2; ++bj) {
                    f32x4 v0 = acc[ai][bj][m][0] * s, v1 = acc[ai][bj][m][1] * s;
#pragma unroll
                    for (int e = 0; e < 4; ++e) { const float a = fmaxf(v0[e], 0.f), b = fmaxf(v1[e], 0.f); v0[e] = a * a; v1[e] = b * b; }
                    *(u32x4*)(O + (size_t)row * 4096 + col0 + bj * HALF) = pack8(v0, v1);
                }
                asm volatile("" ::: "memory");
            }
    }
};

struct EpiGlu {
    static constexpr bool PERM = true, AFTER_DRAIN = false;
    bf16_t* O; const float* ssp; const float* bias;
    __device__ __forceinline__ void operator()(const f32x4 (&acc)[2][2][4][2], const Unit& u, int wr, int wc, int fr, int fq) const {
        const int row0 = u.pm * BM + wr * 64 + fr, col0 = u.pn * HALF + wc * 32 + 8 * fq;
        const f32x4 bv0 = *(const f32x4*)(bias + col0), bv1 = *(const f32x4*)(bias + col0 + 4), bg0 = *(const f32x4*)(bias + 1024 + col0), bg1 = *(const f32x4*)(bias + 1024 + col0 + 4);
#pragma unroll
        for (int ai = 0; ai < 2; ++ai)
#pragma unroll
            for (int m = 0; m < 4; ++m) {
                const int row = row0 + ai * HALF + m * 16; const float s = row_inv_rms(ssp, row);
                f32x4 a0 = acc[ai][0][m][0] * s + bv0, a1 = acc[ai][0][m][1] * s + bv1;
                const f32x4 g0 = acc[ai][1][m][0] * s + bg0, g1 = acc[ai][1][m][1] * s + bg1;
#pragma unroll
                for (int e = 0; e < 4; ++e) {
                    a0[e] = a0[e] * __builtin_amdgcn_rcpf(1.0f + __builtin_amdgcn_exp2f(-1.4426950408889634f * g0[e]));
                    a1[e] = a1[e] * __builtin_amdgcn_rcpf(1.0f + __builtin_amdgcn_exp2f(-1.4426950408889634f * g1[e]));
                }
                *(u32x4*)(O + (size_t)row * 1024 + col0) = pack8(a0, a1);
                asm volatile("" ::: "memory");
            }
    }
};

template <class Epi, class Sched, bool ALIGN_EPI = false, bool SP2 = false>
__device__ __forceinline__ void gemm_phase(PG8_LAS unsigned char* lds, const Gemm g, const Sched& S, const Epi& E) {
    const int tid = opaque_tid(), wid = __builtin_amdgcn_readfirstlane(tid >> 6), lane = tid & 63, wr = wid >> 2, wc = wid & 3, fr = lane & 15, fq = lane >> 4;
    const int K = g.K, nt = K / BK;
    unsigned voffA[2], voffB[2];
#pragma unroll
    for (int i = 0; i < 2; ++i) { int R, C; stage_rc(tid * 16 + i * 8192, R, C); const int Rb = Epi::PERM ? ((R & ~31) + perm32(R & 31)) : R;
        voffA[i] = (unsigned)(R * K + C) * 2u; voffB[i] = (unsigned)(Rb * K + C) * 2u; }
    const size_t kstep = (size_t)(BK * 2);
    const size_t hstep = (size_t)HALF * K * 2;
    const size_t tstep = 2 * hstep;
    const unsigned ldsw = (unsigned)wid * 1024u;
    const int aoff = lds_byte(wr * 64 + fr, fq * 8), boff = lds_byte(wc * 32 + fr, fq * 8);
#define PG8_SA(b, h) (((b) * 2 + (h)) * HTB)
#define PG8_SB(b, h) ((4 + (b) * 2 + (h)) * HTB)
#define PG8_STAGE(bufoff, gbase, voff) do { _Pragma("unroll") for (int _i = 0; _i < 2; ++_i) \
        __builtin_amdgcn_global_load_lds((const unsigned*)((const char*)(gbase) + (voff)[_i]), (PG8_LAS unsigned*)(lds + (bufoff) + ldsw + _i * 8192), 16, 0, 0); } while (0)
#define PG8_LDA(dst, b, h) do { _Pragma("unroll") for (int m = 0; m < 4; ++m) _Pragma("unroll") for (int k = 0; k < 2; ++k) dst[m][k] = *(const PG8_LAS bf16x8*)(lds + PG8_SA(b, h) + aoff + m * 2048 + k * 1024); } while (0)
#define PG8_LDB(dst, b, h) do { _Pragma("unroll") for (int n = 0; n < 2; ++n) _Pragma("unroll") for (int k = 0; k < 2; ++k) dst[n][k] = *(const PG8_LAS bf16x8*)(lds + PG8_SB(b, h) + boff + n * 2048 + k * 1024); } while (0)
#define PG8_MMA(ai, bj, At, Bt) do { __builtin_amdgcn_s_setprio(1); _Pragma("unroll") for (int m = 0; m < 4; ++m) _Pragma("unroll") for (int n = 0; n < 2; ++n) _Pragma("unroll") for (int k = 0; k < 2; ++k) \
        acc[ai][bj][m][n] = __builtin_amdgcn_mfma_f32_16x16x32_bf16(Bt[n][k], At[m][k], acc[ai][bj][m][n], 0, 0, 0); __builtin_amdgcn_s_setprio(0); } while (0)
#define PG8_WAIT_V(n) asm volatile("s_waitcnt vmcnt(" #n ")" ::: "memory")
#define PG8_WAIT_L(n) asm volatile("s_waitcnt lgkmcnt(" #n ")" ::: "memory")
#define PG8_BAR __builtin_amdgcn_s_barrier()
#define PG8_SCHED __builtin_amdgcn_sched_barrier(0)
    Unit cur, nxt; int ui = 0;
    if (!S.next(0, cur)) return;
    f32x4 acc[2][2][4][2];
#pragma unroll
    for (int a = 0; a < 2; ++a)
#pragma unroll
        for (int b = 0; b < 2; ++b)
#pragma unroll
            for (int m = 0; m < 4; ++m)
#pragma unroll
                for (int n = 0; n < 2; ++n) acc[a][b][m][n] = (f32x4){0.f, 0.f, 0.f, 0.f};
    bf16x8 At[4][2], B0[2][2], B1[2][2];
    const char* cA = (const char*)g.A + (size_t)cur.pm * tstep; const char* cB = (const char*)g.Bt + (size_t)cur.pn * tstep;
    S.a_ready(cur);
    if constexpr (SP2) {
        PG8_STAGE(PG8_SB(0, 0), cB, voffB); PG8_STAGE(PG8_SB(0, 1), cB + hstep, voffB); PG8_STAGE(PG8_SA(0, 0), cA, voffA); PG8_STAGE(PG8_SA(0, 1), cA + hstep, voffA);
        if (wr == 1) PG8_BAR;
        PG8_WAIT_V(2); PG8_BAR;
        PG8_STAGE(PG8_SB(1, 0), cB + kstep, voffB); PG8_STAGE(PG8_SA(1, 0), cA + kstep, voffA); PG8_STAGE(PG8_SB(1, 1), cB + hstep + kstep, voffB);
        PG8_WAIT_V(6); PG8_BAR;
    } else {
        PG8_STAGE(PG8_SB(0, 0), cB, voffB); PG8_STAGE(PG8_SA(0, 0), cA, voffA); PG8_STAGE(PG8_SB(0, 1), cB + hstep, voffB); PG8_STAGE(PG8_SA(0, 1), cA + hstep, voffA);
        if (wr == 1) PG8_BAR;
        PG8_WAIT_V(4); PG8_BAR;
        PG8_STAGE(PG8_SB(1, 0), cB + kstep, voffB); PG8_STAGE(PG8_SA(1, 0), cA + kstep, voffA); PG8_STAGE(PG8_SB(1, 1), cB + hstep + kstep, voffB);
        PG8_WAIT_V(6); PG8_BAR;
    }
    for (;;) {
        const bool has_next = S.next(ui + 1, nxt);
        const char* nA = has_next ? (const char*)g.A + (size_t)nxt.pm * tstep : cA; const char* nB = has_next ? (const char*)g.Bt + (size_t)nxt.pn * tstep : cB;
        for (int t = 0; t < nt; t += 2) {
            const bool last = (t == nt - 2);
            const char* a1 = cA + (size_t)(t + 1) * kstep;
            const char* a2 = last ? nA : cA + (size_t)(t + 2) * kstep; const char* b2 = last ? nB : cB + (size_t)(t + 2) * kstep;
            const char* a3 = a2 + kstep; const char* b3 = b2 + kstep;
            if (last && has_next) S.a_ready(nxt);
            if constexpr (SP2) {
            PG8_LDB(B0, 0, 0); PG8_LDB(B1, 0, 1); PG8_SCHED; PG8_LDA(At, 0, 0); PG8_STAGE(PG8_SA(1, 1), a1 + hstep, voffA);
            PG8_WAIT_V(8); PG8_WAIT_L(0); PG8_BAR; PG8_MMA(0, 0, At, B0); PG8_MMA(0, 1, At, B1); PG8_BAR; PG8_SCHED;
            PG8_LDA(At, 0, 1); PG8_STAGE(PG8_SB(0, 0), b2, voffB); PG8_STAGE(PG8_SB(0, 1), b2 + hstep, voffB); PG8_STAGE(PG8_SA(0, 0), a2, voffA);
            PG8_WAIT_V(8); PG8_WAIT_L(0); PG8_BAR; PG8_MMA(1, 0, At, B0); PG8_MMA(1, 1, At, B1); PG8_BAR; PG8_SCHED;
            PG8_LDB(B0, 1, 0); PG8_LDB(B1, 1, 1); PG8_SCHED; PG8_LDA(At, 1, 0); PG8_STAGE(PG8_SA(0, 1), a2 + hstep, voffA);
            PG8_WAIT_V(8); PG8_WAIT_L(0); PG8_BAR; PG8_MMA(0, 0, At, B0); PG8_MMA(0, 1, At, B1); PG8_BAR; PG8_SCHED;
            PG8_LDA(At, 1, 1); PG8_STAGE(PG8_SB(1, 0), b3, voffB); PG8_STAGE(PG8_SB(1, 1), b3 + hstep, voffB); PG8_STAGE(PG8_SA(1, 0), a3, voffA);
            PG8_WAIT_V(8); PG8_WAIT_L(0); PG8_BAR; PG8_MMA(1, 0, At, B0); PG8_MMA(1, 1, At, B1); PG8_BAR; PG8_SCHED;
            } else {
            PG8_LDB(B0, 0, 0); PG8_SCHED; PG8_LDA(At, 0, 0); PG8_STAGE(PG8_SA(1, 1), a1 + hstep, voffA);
            PG8_WAIT_L(8); PG8_BAR; PG8_WAIT_L(0); PG8_MMA(0, 0, At, B0); PG8_BAR; PG8_SCHED;
            PG8_LDB(B1, 0, 1); PG8_STAGE(PG8_SB(0, 0), b2, voffB);
            PG8_BAR; PG8_WAIT_L(0); PG8_MMA(0, 1, At, B1); PG8_BAR;
            PG8_LDA(At, 0, 1); PG8_STAGE(PG8_SA(0, 0), a2, voffA);
            PG8_BAR; PG8_WAIT_L(0); PG8_MMA(1, 0, At, B0); PG8_BAR; PG8_SCHED;
            PG8_STAGE(PG8_SB(0, 1), b2 + hstep, voffB);
            PG8_WAIT_V(6); PG8_BAR; PG8_MMA(1, 1, At, B1); PG8_BAR;
            PG8_LDB(B0, 1, 0); PG8_SCHED; PG8_LDA(At, 1, 0); PG8_STAGE(PG8_SA(0, 1), a2 + hstep, voffA);
            PG8_WAIT_L(8); PG8_BAR; PG8_WAIT_L(0); PG8_MMA(0, 0, At, B0); PG8_BAR; PG8_SCHED;
            PG8_LDB(B1, 1, 1); PG8_STAGE(PG8_SB(1, 0), b3, voffB);
            PG8_BAR; PG8_WAIT_L(0); PG8_MMA(0, 1, At, B1); PG8_BAR;
            PG8_LDA(At, 1, 1); PG8_STAGE(PG8_SA(1, 0), a3, voffA);
            PG8_BAR; PG8_WAIT_L(0); PG8_MMA(1, 0, At, B0); PG8_BAR; PG8_SCHED;
            PG8_STAGE(PG8_SB(1, 1), b3 + hstep, voffB);
            PG8_WAIT_V(6); PG8_BAR; PG8_MMA(1, 1, At, B1); PG8_BAR;
            }
        }
        if constexpr (ALIGN_EPI) { if (wr == 0) PG8_BAR; }
        if constexpr (!Epi::AFTER_DRAIN) { E(acc, cur, wr, wc, fr, fq); S.done(cur); }
        if (!has_next) break;
#pragma unroll
        for (int a = 0; a < 2; ++a)
#pragma unroll
            for (int b = 0; b < 2; ++b)
#pragma unroll
                for (int m = 0; m < 4; ++m)
#pragma unroll
                    for (int n = 0; n < 2; ++n) acc[a][b][m][n] = (f32x4){0.f, 0.f, 0.f, 0.f};
        cur = nxt; cA = nA; cB = nB; ++ui;
        if constexpr (ALIGN_EPI) { if (wr == 1) PG8_BAR; }
    }
    PG8_WAIT_V(0);
    if constexpr (!ALIGN_EPI) { if (wr == 0) PG8_BAR; }
    PG8_BAR;
    if constexpr (Epi::AFTER_DRAIN) { E.fused(acc, cur, wr, wc, fr, fq, lds, wid, lane); S.done(cur); }
#undef PG8_SA
#undef PG8_SB
#undef PG8_STAGE
#undef PG8_LDA
#undef PG8_LDB
#undef PG8_MMA
#undef PG8_WAIT_V
#undef PG8_WAIT_L
#undef PG8_BAR
#undef PG8_SCHED
}
}

#define LAS __attribute__((address_space(3)))
typedef unsigned short bf16;
typedef unsigned u32x4 __attribute__((ext_vector_type(4)));
typedef unsigned u32x2 __attribute__((ext_vector_type(2)));
typedef float f32x4 __attribute__((ext_vector_type(4)));
typedef float f32x2 __attribute__((ext_vector_type(2)));
typedef float f32x16 __attribute__((ext_vector_type(16)));
typedef short bf16x8 __attribute__((ext_vector_type(8)));
typedef short s16x4 __attribute__((ext_vector_type(4)));
#define LDS_WAIT() asm volatile("s_waitcnt lgkmcnt(0)" ::: "memory")

constexpr int NWAVES = 8;
constexpr int BATCH = 4, SEQ = 8192, DM = 1024, M = BATCH * SEQ, DFF = 4096, INW = 2048;
constexpr int LDS_BYTES = 147456;
constexpr size_t MiB = 1u << 20;
constexpr size_t WS_CTL = 0;
constexpr size_t WS_WIN = 1 * MiB;
constexpr size_t WS_WCAT = 5 * MiB;
constexpr size_t WS_WUP = 7 * MiB;
constexpr size_t WS_WDN = 23 * MiB;
constexpr size_t WS_PW1 = 39 * MiB;
constexpr size_t WS_PW2 = 43 * MiB;
constexpr size_t WS_ROPE = 45 * MiB;
constexpr size_t WS_SSP = 46 * MiB;
constexpr size_t WS_AB = 48 * MiB;
constexpr size_t WS_BIG = 112 * MiB;
constexpr size_t WS_Z = WS_BIG, WS_CAT = WS_BIG + 128 * MiB, WS_HID = WS_BIG, WS_G = WS_BIG, WS_Y = WS_BIG + 64 * MiB;
constexpr size_t WS_END = WS_BIG + 256 * MiB;

__device__ __forceinline__ unsigned pk2(float lo, float hi) { return pg8::cvt_pk_bf16(lo, hi); }
__device__ __forceinline__ float bflo(unsigned v) { return __uint_as_float(v << 16); }
__device__ __forceinline__ float bfhi(unsigned v) { return __uint_as_float(v & 0xffff0000u); }
__device__ __forceinline__ float wave_sum(float v) {
#pragma unroll
    for (int o = 1; o < 64; o <<= 1) v += __shfl_xor(v, o);
    return v;
}

__device__ __forceinline__ void tr_item(const float* W, int ldw, int k0, int n0, const float* gain, bf16* WT, int ldt, int drow0, LAS float* scr, int lane) {
#pragma unroll 8
    for (int i = 0; i < 32; ++i) { const int kk = 2 * i + (lane >> 5); const float g = gain ? gain[k0 + kk] : 1.0f; scr[kk * 33 + (lane & 31)] = W[(size_t)(k0 + kk) * ldw + n0 + (lane & 31)] * g; }
    LDS_WAIT();
    const int c = lane & 7;
#pragma unroll
    for (int j = 0; j < 4; ++j) { const int n = (lane >> 3) + 8 * j; const LAS float* s = scr + (8 * c) * 33 + n;
        u32x4 o; o.x = pk2(s[0 * 33], s[1 * 33]); o.y = pk2(s[2 * 33], s[3 * 33]); o.z = pk2(s[4 * 33], s[5 * 33]); o.w = pk2(s[6 * 33], s[7 * 33]);
        *(u32x4*)(WT + (size_t)(drow0 + n) * ldt + k0 + 8 * c) = o; }
    LDS_WAIT();
}
__device__ __forceinline__ void tr_matrix_item(const float* W, int K, int N, int kbase, const float* gain, bf16* WT, int ldt, int item, bool glu, LAS float* scr, int lane) {
    const int nblk = N / 32, kb = item / nblk, nb = item % nblk; const int k0 = kbase + 64 * kb, n0 = 32 * nb;
    int drow0 = n0;
    if (glu) { const int half = n0 >= 1024 ? 1 : 0, j = n0 - half * 1024; drow0 = 256 * (j >> 7) + 128 * half + (j & 127); }
    tr_item(W, N, k0, n0, gain, WT, ldt, drow0, scr, lane);
}

struct Args {
    const float* in[23]; float* out; unsigned char* ws; float invf[8];
};

__device__ __forceinline__ void prologue(const Args& a, LAS unsigned char* lds, int vcu, int G, int wave, int lane) {
    unsigned char* ws = a.ws;
    LAS float* scr = (LAS float*)(lds + wave * 16384);
    const int gw = vcu * NWAVES + wave, NGW = G * NWAVES;
    const float* x = a.in[0]; const float* mix_norm = a.in[1]; const float* mlp_norm = a.in[2]; const float* w_up = a.in[3]; const float* w_down = a.in[4];
    const float* w_in = a.in[6]; const float* pool_w = a.in[7]; const float* pool_scale = a.in[8]; const float* w_out = a.in[14];
    const float* pw1 = a.in[15]; const float* pw2 = a.in[21];
    bf16* WIN = (bf16*)(ws + WS_WIN); bf16* WCAT = (bf16*)(ws + WS_WCAT); bf16* WUP = (bf16*)(ws + WS_WUP); bf16* WDN = (bf16*)(ws + WS_WDN);
    bf16* PW1 = (bf16*)(ws + WS_PW1); bf16* PW2 = (bf16*)(ws + WS_PW2);
    constexpr int I_IN = 16 * 64, I_OUT = 8 * 32, I_UP = 16 * 128, I_DN = 64 * 32, I_PW1 = 16 * 64, I_PW2 = 16 * 32;
    constexpr int NITEMS = I_IN + I_OUT + 2 * I_UP + 2 * I_DN + I_PW1 + I_PW2;
    for (int it = gw; it < NITEMS; it += NGW) {
        int r = it;
        if (r < I_IN) { tr_matrix_item(w_in, 1024, 2048, 0, nullptr, WIN, 1024, r, false, scr, lane); continue; } r -= I_IN;
        if (r < I_OUT) { tr_matrix_item(w_out, 512, 1024, 512, nullptr, WCAT, 1024, r, false, scr, lane); continue; } r -= I_OUT;
        if (r < I_UP) { tr_matrix_item(w_up, 1024, 4096, 0, mlp_norm, WUP, 1024, r, false, scr, lane); continue; } r -= I_UP;
        if (r < I_UP) { tr_matrix_item(w_up + (size_t)1024 * 4096, 1024, 4096, 0, mlp_norm + 1024, WUP + (size_t)4096 * 1024, 1024, r, false, scr, lane); continue; } r -= I_UP;
        if (r < I_DN) { tr_matrix_item(w_down, 4096, 1024, 0, nullptr, WDN, 4096, r, false, scr, lane); continue; } r -= I_DN;
        if (r < I_DN) { tr_matrix_item(w_down + (size_t)4096 * 1024, 4096, 1024, 0, nullptr, WDN + (size_t)1024 * 4096, 4096, r, false, scr, lane); continue; } r -= I_DN;
        if (r < I_PW1) { tr_matrix_item(pw1, 1024, 2048, 0, mix_norm + 1024, PW1, 1024, r, true, scr, lane); continue; } r -= I_PW1;
        tr_matrix_item(pw2, 1024, 1024, 0, nullptr, PW2, 1024, r, false, scr, lane);
    }
    for (int it = gw; it < 16 * 64; it += NGW) {
        const int nb = it & 15, kb = it >> 4; const int n = nb * 64 + lane, k0 = kb * 8, g = k0 >> 7;
        float acc8[8];
#pragma unroll
        for (int i = 0; i < 8; ++i) acc8[i] = 0.f;
        for (int d = 0; d < 128; ++d) {
            const float wv = w_out[(size_t)(g * 128 + d) * 1024 + n] * pool_scale[g * 128 + d];
#pragma unroll
            for (int i = 0; i < 8; ++i) acc8[i] += pool_w[(size_t)(k0 + i) * 128 + d] * wv;
        }
        u32x4 o; o.x = pk2(acc8[0], acc8[1]); o.y = pk2(acc8[2], acc8[3]); o.z = pk2(acc8[4], acc8[5]); o.w = pk2(acc8[6], acc8[7]);
        *(u32x4*)(WCAT + (size_t)n * 1024 + k0) = o;
    }
    {
        float* rope = (float*)(ws + WS_ROPE);
        const int gt = (vcu * NWAVES + wave) * 64 + lane, NGT = NGW * 64;
        for (int idx = gt; idx < 8192 * 8; idx += NGT) {
            const int pos = idx >> 3, i = idx & 7;
            const float angf = (float)pos * a.invf[i];
            const double ang = (double)angf;
            const double n = __builtin_rint(ang * 0.15915494309189535);
            const double y = ang - n * 6.283185307179586476925;
            const double y2 = y * y;
            double sp = 1.0, cp = 1.0;
#pragma unroll
            for (int k = 13; k >= 1; --k) { sp = 1.0 - sp * y2 / (double)((2 * k) * (2 * k + 1)); cp = 1.0 - cp * y2 / (double)((2 * k - 1) * (2 * k)); }
            rope[idx] = (float)cp; rope[65536 + idx] = (float)(y * sp);
        }
    }
    {
        bf16* XN = (bf16*)(ws + WS_AB);
        f32x4 gv[4];
#pragma unroll
        for (int j = 0; j < 4; ++j) gv[j] = ((const f32x4*)mix_norm)[lane + 64 * j];
        for (int m = gw; m < M; m += NGW) {
            const f32x4* xr = (const f32x4*)(x + (size_t)m * DM) + lane;
            f32x4 v[4]; float s = 0.f;
#pragma unroll
            for (int j = 0; j < 4; ++j) { v[j] = xr[64 * j]; s += (v[j][0] * v[j][0] + v[j][1] * v[j][1]) + (v[j][2] * v[j][2] + v[j][3] * v[j][3]); }
            const float inv = 1.0f / sqrtf(wave_sum(s) * (1.0f / DM) + 1e-6f);
            u32x2* o8 = (u32x2*)(XN + (size_t)m * DM) + lane;
#pragma unroll
            for (int j = 0; j < 4; ++j) { u32x2 o; o.x = pk2(v[j][0] * inv * gv[j][0], v[j][1] * inv * gv[j][1]); o.y = pk2(v[j][2] * inv * gv[j][2], v[j][3] * inv * gv[j][3]); o8[64 * j] = o; }
        }
    }
}

__device__ __forceinline__ void pool_phase(const bf16* U, bf16* CAT, int vcu, int G, int tid) {
    const int gt = vcu * (NWAVES * 64) + tid, NGT = G * NWAVES * 64;
    for (int it = gt; it < M * 64; it += NGT) {
        const int row = it >> 6, c8 = it & 63; const int t = row & (SEQ - 1); const int g = c8 >> 4; const int w = 2 << g;
        const int cnt = (t + 1 < w) ? (t + 1) : w;
        float s[8];
#pragma unroll
        for (int e = 0; e < 8; ++e) s[e] = 0.f;
        float tok[8];
        for (int j = 0; j < cnt; ++j) {
            const u32x4 v = *(const u32x4*)(U + (size_t)(row - j) * 512 + c8 * 8);
            const float f[8] = {bflo(v.x), bfhi(v.x), bflo(v.y), bfhi(v.y), bflo(v.z), bfhi(v.z), bflo(v.w), bfhi(v.w)};
#pragma unroll
            for (int e = 0; e < 8; ++e) { s[e] += f[e]; if (j == 0) tok[e] = f[e]; }
        }
        const float ic = 1.0f / (float)cnt;
        u32x4 o; o.x = pk2(s[0] * ic - tok[0], s[1] * ic - tok[1]); o.y = pk2(s[2] * ic - tok[2], s[3] * ic - tok[3]);
        o.z = pk2(s[4] * ic - tok[4], s[5] * ic - tok[5]); o.w = pk2(s[6] * ic - tok[6], s[7] * ic - tok[7]);
        *(u32x4*)(CAT + (size_t)row * 1024 + c8 * 8) = o;
    }
}

namespace att {
constexpr int KBUF = 0, VBUF = 32768, XOFF = 65536, WSF = 131072;
__device__ __forceinline__ int crow(int r, int hi) { return (r & 3) + 8 * (r >> 2) + 4 * hi; }
__device__ __forceinline__ void glds16(const void* gsrc, unsigned lds_dst) { unsigned keep;
    asm volatile("s_mov_b32 %0, m0\n\ts_mov_b32 m0, %2\n\ts_nop 0\n\tglobal_load_lds_dwordx4 %1, off\n\ts_mov_b32 m0, %0" : "=&s"(keep) : "v"(gsrc), "s"(lds_dst) : "memory"); }
typedef short v4i16_t __attribute__((ext_vector_type(4)));
__device__ __forceinline__ s16x4 vtr(LAS const unsigned char* p) { return __builtin_bit_cast(s16x4, __builtin_amdgcn_ds_read_tr16_b64_v4i16((LAS v4i16_t*)p)); }
#define MX3(a, b, c) __builtin_fmaxf(__builtin_fmaxf((a), (b)), (c))
__device__ __forceinline__ float rowmax(const f32x16& p0, const f32x16& p1) {
    float a = MX3(p0[0], p0[1], p1[0]), b = MX3(p0[2], p0[3], p1[1]); a = MX3(a, p1[2], p1[3]);
#pragma unroll
    for (int r = 4; r < 16; r += 4) { a = MX3(a, p0[r], p0[r + 1]); b = MX3(b, p0[r + 2], p0[r + 3]); a = MX3(a, p1[r], p1[r + 1]); b = MX3(b, p1[r + 2], p1[r + 3]); }
    float m = __builtin_fmaxf(a, b); auto rr = __builtin_amdgcn_permlane32_swap(__float_as_uint(m), __float_as_uint(m), false, false);
    return __builtin_fmaxf(__uint_as_float(rr[0]), __uint_as_float(rr[1]));
}
#define MFMA32(a, b, c) __builtin_amdgcn_mfma_f32_32x32x16_bf16(a, b, c, 0, 0, 0)

__device__ __forceinline__ void attn_unit(int b, int h, int qb, const bf16* Q, const bf16* K, const bf16* V, bf16* CAT, const float* subln, float lam, LAS unsigned char* lds) {
    const int tid = opaque_tid(), lane = tid & 63, r32 = lane & 31, hi = lane >> 5; const int wid = __builtin_amdgcn_readfirstlane(tid >> 6);
    const int comp = wid >> 2, wq = wid & 3;
    const size_t rowbase = (size_t)b * SEQ; const int q0 = qb * 128; const int NT = (q0 + 128) / 64;
    const unsigned lds0 = (unsigned)(size_t)lds;
    LAS float* wsf = (LAS float*)(lds + WSF) + wid * 64;
    const bf16* Qw = Q + (rowbase + q0 + wq * 32 + r32) * 512 + h * 128 + comp * 64;
    bf16x8 qr[4];
#pragma unroll
    for (int d0 = 0; d0 < 4; ++d0) qr[d0] = *(const bf16x8*)(Qw + d0 * 16 + hi * 8);
    const bf16* ksrc[2]; const bf16* vsrc[2]; unsigned kdst[2], vdst[2];
#pragma unroll
    for (int i = 0; i < 2; ++i) { const int p = 2 * wid + i; const int kc = p >> 3, ch = p & 7, db = p >> 2, rg = p & 3;
        ksrc[i] = K + (rowbase + lane) * 512 + h * 128 + kc * 64 + ch * 8; kdst[i] = lds0 + KBUF + kc * 8192 + ch * 1024;
        vsrc[i] = V + (rowbase + 16 * rg + (lane >> 2)) * 512 + h * 128 + db * 32 + (lane & 3) * 8; vdst[i] = lds0 + VBUF + db * 4096 + rg * 1024; }
#define DMA_TILE(t, buf) do { _Pragma("unroll") for (int i_ = 0; i_ < 2; ++i_) { \
        glds16(ksrc[i_] + (size_t)(t) * 64 * 512, (unsigned)__builtin_amdgcn_readfirstlane(kdst[i_] + (buf) * 16384)); \
        glds16(vsrc[i_] + (size_t)(t) * 64 * 512, (unsigned)__builtin_amdgcn_readfirstlane(vdst[i_] + (buf) * 16384)); } } while (0)
    f32x16 o[4];
#pragma unroll
    for (int d0 = 0; d0 < 4; ++d0) o[d0] = f32x16{};
    float mref = -INFINITY, l = 0.f;
    const int qrel = wq * 32 + r32;
    asm volatile("s_waitcnt vmcnt(0)" ::: "memory");
    DMA_TILE(0, 0);
    for (int t = 0; t < NT; ++t) {
        const int buf = t & 1;
        if (t + 1 < NT) { DMA_TILE(t + 1, buf ^ 1); asm volatile("s_waitcnt vmcnt(4)" ::: "memory"); }
        else { asm volatile("s_waitcnt vmcnt(0)" ::: "memory"); }
        __builtin_amdgcn_s_barrier(); asm volatile("" ::: "memory");
        LAS const unsigned char* kp = lds + KBUF + buf * 16384 + comp * 8192 + hi * 1024 + r32 * 16;
        f32x16 p0 = f32x16{}, p1 = f32x16{};
#pragma unroll
        for (int d0 = 0; d0 < 4; ++d0) {
            const bf16x8 k0 = *(LAS const bf16x8*)(kp + d0 * 2048), k1 = *(LAS const bf16x8*)(kp + d0 * 2048 + 512);
            p0 = MFMA32(k0, qr[d0], p0); p1 = MFMA32(k1, qr[d0], p1);
        }
        if (t >= NT - 2) {
            const int kb = 64 * (t - (NT - 2)) + 4 * hi;
#pragma unroll
            for (int r = 0; r < 16; ++r) { const int kv = kb + (r & 3) + 8 * (r >> 2); if (kv > qrel) p0[r] = -INFINITY; if (kv + 32 > qrel) p1[r] = -INFINITY; }
        }
        const float rm = rowmax(p0, p1);
        if (__any(rm > mref + 8.0f)) {
            const float mnew = __builtin_fmaxf(mref, rm); const float alpha = __builtin_amdgcn_exp2f(mref - mnew);
            mref = mnew; l *= alpha;
            if (hi == 0) wsf[r32] = alpha;
            LDS_WAIT();
#pragma unroll
            for (int r = 0; r < 16; ++r) { const float f = wsf[crow(r, hi)];
#pragma unroll
                for (int d0 = 0; d0 < 4; ++d0) o[d0][r] *= f; }
        }
        float sacc = 0.f;
#pragma unroll
        for (int r = 0; r < 16; ++r) { p0[r] = __builtin_amdgcn_exp2f(p0[r] - mref); p1[r] = __builtin_amdgcn_exp2f(p1[r] - mref); sacc += p0[r] + p1[r]; }
        l += sacc;
        bf16x8 pa[4];
        { u32x4 w;
          w.x = pk2(p0[0], p0[1]); w.y = pk2(p0[2], p0[3]); w.z = pk2(p0[4], p0[5]); w.w = pk2(p0[6], p0[7]); pa[0] = __builtin_bit_cast(bf16x8, w);
          w.x = pk2(p0[8], p0[9]); w.y = pk2(p0[10], p0[11]); w.z = pk2(p0[12], p0[13]); w.w = pk2(p0[14], p0[15]); pa[1] = __builtin_bit_cast(bf16x8, w);
          w.x = pk2(p1[0], p1[1]); w.y = pk2(p1[2], p1[3]); w.z = pk2(p1[4], p1[5]); w.w = pk2(p1[6], p1[7]); pa[2] = __builtin_bit_cast(bf16x8, w);
          w.x = pk2(p1[8], p1[9]); w.y = pk2(p1[10], p1[11]); w.z = pk2(p1[12], p1[13]); w.w = pk2(p1[14], p1[15]); pa[3] = __builtin_bit_cast(bf16x8, w); }
        LAS const unsigned char* vp = lds + VBUF + buf * 16384 + ((lane >> 4) & 1) * 32 + (lane & 3) * 8 + (4 * hi + ((lane & 15) >> 2)) * 64;
#pragma unroll
        for (int d0 = 0; d0 < 4; ++d0)
#pragma unroll
            for (int ks = 0; ks < 4; ++ks) {
                const s16x4 lo = vtr(vp + d0 * 4096 + ks * 1024), hh = vtr(vp + d0 * 4096 + ks * 1024 + 512);
                const bf16x8 vf = {lo[0], lo[1], lo[2], lo[3], hh[0], hh[1], hh[2], hh[3]};
                o[d0] = MFMA32(pa[ks], vf, o[d0]);
            }
        LDS_WAIT();
        __builtin_amdgcn_s_barrier(); asm volatile("" ::: "memory");
    }
#undef DMA_TILE
    { auto rr = __builtin_amdgcn_permlane32_swap(__float_as_uint(l), __float_as_uint(l), false, false); l = __uint_as_float(rr[0]) + __uint_as_float(rr[1]); }
    if (hi == 0) wsf[r32] = 1.0f / l;
    LDS_WAIT();
    float rli[16];
#pragma unroll
    for (int r = 0; r < 16; ++r) rli[r] = wsf[crow(r, hi)];
    LAS float* X = (LAS float*)(lds + XOFF);
    if (comp == 1) {
#pragma unroll
        for (int d0 = 0; d0 < 4; ++d0)
#pragma unroll
            for (int r = 0; r < 16; ++r) X[((wq * 4 + d0) * 16 + r) * 64 + lane] = lam * o[d0][r] * rli[r];
    }
    LDS_WAIT();
    __builtin_amdgcn_s_barrier(); asm volatile("" ::: "memory");
    if (comp == 0) {
        float ssq[16];
#pragma unroll
        for (int r = 0; r < 16; ++r) ssq[r] = 0.f;
#pragma unroll
        for (int d0 = 0; d0 < 4; ++d0)
#pragma unroll
            for (int r = 0; r < 16; ++r) { const float v = o[d0][r] * rli[r] - X[((wq * 4 + d0) * 16 + r) * 64 + lane]; o[d0][r] = v; ssq[r] += v * v; }
#pragma unroll
        for (int r = 0; r < 16; ++r) {
            float s = ssq[r];
            s += __shfl_xor(s, 1); s += __shfl_xor(s, 2); s += __shfl_xor(s, 4); s += __shfl_xor(s, 8); s += __shfl_xor(s, 16);
            ssq[r] = 0.8f / sqrtf(s * (1.0f / 128.0f) + 1e-5f);
        }
        bf16* Ow = CAT + (rowbase + q0 + wq * 32) * 1024 + 512 + h * 128 + r32;
#pragma unroll
        for (int d0 = 0; d0 < 4; ++d0) { const float gsub = subln[d0 * 32 + r32];
#pragma unroll
            for (int r = 0; r < 16; ++r) { const float y = o[d0][r] * ssq[r] * gsub; Ow[(size_t)crow(r, hi) * 1024 + d0 * 32] = (bf16)(pk2(y, 0.f) & 0xffffu); } }
    }
    LDS_WAIT();
    __builtin_amdgcn_s_barrier(); asm volatile("" ::: "memory");
}
}

__device__ __forceinline__ void conv_phase(LAS unsigned char* lds, const bf16* Gt, bf16* Y, const float* dw_w, const float* dw_b, const float* ln_g, const float* ln_b, int vcu, int G) {
    const int tid = opaque_tid(), lane = tid & 63; const int wid = tid >> 6;
    const int c0 = 2 * tid;
    LAS float* red = (LAS float*)(lds + 62 * 2048);
    LAS float* mr = (LAS float*)(lds + 62 * 2048 + 2048);
    const f32x2 bia = *(const f32x2*)(dw_b + c0), gam = *(const f32x2*)(ln_g + c0), bet = *(const f32x2*)(ln_b + c0);
    for (int tile = vcu; tile < 1024; tile += G) {
        const int b = tile >> 8, t0 = (tile & 255) * 32;
        const float* dww = dw_w; asm volatile("" : "+s"(dww));
#pragma unroll 4
        for (int p = tid; p < 62 * 128; p += NWAVES * 64) {
            const int rr = p >> 7, pc = p & 127; const int t = t0 - 30 + rr; u32x4 v = {0u, 0u, 0u, 0u};
            if (t >= 0) v = *(const u32x4*)(Gt + ((size_t)b * SEQ + t) * 1024 + pc * 8);
            *(LAS u32x4*)(lds + rr * 2048 + pc * 16) = v;
        }
        __syncthreads();
        f32x2 av[32];
#pragma unroll
        for (int tt = 0; tt < 32; ++tt) av[tt] = bia;
#pragma unroll
        for (int half = 0; half < 2; ++half) {
            const int j0 = half * 16, nj = half ? 15 : 16;
            f32x2 wv[16];
#pragma unroll
            for (int j = 0; j < 16; ++j) { if (j < nj) wv[j] = *(const f32x2*)(dww + (j0 + j) * 1024 + c0); else wv[j] = (f32x2){0.f, 0.f}; }
#pragma unroll
            for (int th = 0; th < 2; ++th) {
#pragma unroll
                for (int q = 0; q < 31; ++q) {
                    const int rr = 16 * th + j0 + q;
                    const unsigned v = *(LAS const unsigned*)(lds + rr * 2048 + tid * 4); const f32x2 x = {bflo(v), bfhi(v)};
#pragma unroll
                    for (int i = 0; i < 16; ++i) { const int j = q - i; if (j >= 0 && j < nj) av[16 * th + i] += wv[j] * x; }
                }
                asm volatile("" ::: "memory");
            }
        }
        float a0[32], a1[32];
#pragma unroll
        for (int tt = 0; tt < 32; ++tt) { a0[tt] = av[tt][0]; a1[tt] = av[tt][1]; }
        float st[32];
        { const bool bit = (lane & 32) != 0;
#pragma unroll
          for (int i = 0; i < 32; ++i) { const float s1 = a0[i] + a1[i], s2 = a0[i] * a0[i] + a1[i] * a1[i]; const float keep = bit ? s2 : s1, send = bit ? s1 : s2; st[i] = keep + __shfl_xor(send, 32); } }
#define TR_STEP(N) { const bool bit = (lane & N) != 0; _Pragma("unroll") for (int i = 0; i < N; ++i) { const float keep = bit ? st[i + N] : st[i], send = bit ? st[i] : st[i + N]; st[i] = keep + __shfl_xor(send, N); } }
        TR_STEP(16) TR_STEP(8) TR_STEP(4) TR_STEP(2) TR_STEP(1)
#undef TR_STEP
        red[wid * 64 + lane] = st[0];
        __syncthreads();
        if (tid < 32) {
            float s1 = 0.f, s2 = 0.f;
#pragma unroll
            for (int w = 0; w < 8; ++w) { s1 += red[w * 64 + tid]; s2 += red[w * 64 + 32 + tid]; }
            const float mean = s1 * (1.0f / 1024.0f); const float var = fmaxf(s2 * (1.0f / 1024.0f) - mean * mean, 0.f);
            mr[2 * tid] = mean; mr[2 * tid + 1] = 1.0f / sqrtf(var + 1e-5f);
        }
        __syncthreads();
#pragma unroll
        for (int tt = 0; tt < 32; ++tt) {
            const float mean = mr[2 * tt], rstd = mr[2 * tt + 1];
            float y0 = (a0[tt] - mean) * rstd * gam[0] + bet[0], y1 = (a1[tt] - mean) * rstd * gam[1] + bet[1];
            y0 = y0 * __builtin_amdgcn_rcpf(1.0f + __builtin_amdgcn_exp2f(-1.4426950408889634f * y0));
            y1 = y1 * __builtin_amdgcn_rcpf(1.0f + __builtin_amdgcn_exp2f(-1.4426950408889634f * y1));
            *(LAS unsigned*)(lds + tt * 2048 + tid * 4) = pk2(y0, y1);
        }
        __syncthreads();
        {
            bf16* yb = Y + ((size_t)b * SEQ + t0) * 1024;
#pragma unroll 2
            for (int p = tid; p < 32 * 128; p += NWAVES * 64) { const int rr = p >> 7, pc = p & 127; *(u32x4*)(yb + (size_t)rr * 1024 + pc * 8) = *(LAS const u32x4*)(lds + rr * 2048 + pc * 16); }
        }
        __syncthreads();
    }
    __syncthreads();
}


__device__ __forceinline__ void final_phase(float* H, const float* ssp, const float* gfin, int vcu, int G, int wave, int lane) {
    const int gw = vcu * NWAVES + wave, NGW = G * NWAVES;
    f32x4 gv[4];
#pragma unroll
    for (int j = 0; j < 4; ++j) gv[j] = ((const f32x4*)gfin)[lane + 64 * j];
    for (int m = gw; m < M; m += NGW) {
        const float inv = pg8::row_inv_rms(ssp, m);
        f32x4* xr = (f32x4*)(H + (size_t)m * DM) + lane;
#pragma unroll
        for (int j = 0; j < 4; ++j) { f32x4 v = xr[64 * j]; v = v * inv * gv[j]; xr[64 * j] = v; }
    }
}

#ifndef PHASE_MASK
#define PHASE_MASK 0xfff
#endif
#define PH(k) ((PHASE_MASK >> (k)) & 1)
__global__ void __launch_bounds__(NWAVES * 64, 2) fwd_megakernel(Args args) {
    extern __shared__ __attribute__((aligned(16))) unsigned char lds_raw[];
    LAS unsigned char* lds = (LAS unsigned char*)lds_raw;
    cg::grid_group grid = cg::this_grid();
    const int tid = threadIdx.x, lane = tid & 63; const int wave = __builtin_amdgcn_readfirstlane(tid >> 6);
    const int G = gridDim.x; const int bx = blockIdx.x; const int vcu = (G % 8 == 0) ? (bx % 8) * (G / 8) + bx / 8 : bx;
    unsigned char* ws = args.ws;
#define WSP(T, off) ((T*)(ws + (off)))
    float* H = args.out;
    if (PH(0)) { const int t_ = opaque_tid(); prologue(args, lds, vcu, G, __builtin_amdgcn_readfirstlane(t_ >> 6), t_ & 63); }
    grid.sync();
    if (PH(1)) { pg8::Gemm g{WSP(bf16, WS_AB), WSP(bf16, WS_WIN), M, INW, DM}; pg8::StaticOrder S; S.init(M, INW, G, bx); pg8::EpiIn E{WSP(bf16, WS_Z), WSP(float, WS_ROPE)};
      pg8::gemm_phase<pg8::EpiIn, pg8::StaticOrder, true, true>(lds, g, S, E); }
    grid.sync();
    if (PH(2)) {
        bf16* Z = WSP(bf16, WS_Z); bf16* CAT = WSP(bf16, WS_CAT);
        pool_phase(Z, CAT, vcu, G, opaque_tid());
        float sa = args.in[9][lane] * args.in[10][lane], sb = args.in[11][lane] * args.in[12][lane];
        sa = wave_sum(sa); sb = wave_sum(sb);
        const float lam = __builtin_amdgcn_exp2f(sa * 1.4426950408889634f) - __builtin_amdgcn_exp2f(sb * 1.4426950408889634f) + 0.2f;
        const bf16* Qp = Z + (size_t)M * 512; const bf16* Kp = Z + (size_t)2 * M * 512; const bf16* Vp = Z + (size_t)3 * M * 512;
        for (int u = vcu; u < 16 * 16; u += G) {
            const int bh = u >> 4, s = u & 15;
#pragma unroll 1
            for (int i = 0; i < 4; ++i) { const int qb = (i == 0) ? s : (i == 1) ? 31 - s : (i == 2) ? 32 + s : 63 - s;
                att::attn_unit(bh >> 2, bh & 3, qb, Qp, Kp, Vp, CAT, args.in[13], lam, lds); }
        }
    }
    grid.sync();
    if (PH(3)) { pg8::Gemm g{WSP(bf16, WS_CAT), WSP(bf16, WS_WCAT), M, DM, DM}; pg8::StaticOrder S; S.init(M, DM, G, bx); pg8::EpiRes E{args.in[0], H, WSP(bf16, WS_AB), nullptr, WSP(float, WS_SSP)};
      pg8::gemm_phase<pg8::EpiRes, pg8::StaticOrder, true, true>(lds, g, S, E); }
    grid.sync();
    if (PH(4)) { pg8::Gemm g{WSP(bf16, WS_AB), WSP(bf16, WS_WUP), M, DFF, DM}; pg8::StaticOrder S; S.init(M, DFF, G, bx); pg8::EpiUp E{WSP(bf16, WS_HID), WSP(float, WS_SSP)};
      pg8::gemm_phase<pg8::EpiUp, pg8::StaticOrder, true, true>(lds, g, S, E); }
    grid.sync();
    if (PH(5)) { pg8::Gemm g{WSP(bf16, WS_HID), WSP(bf16, WS_WDN), M, DM, DFF}; pg8::StaticOrder S; S.init(M, DM, G, bx); pg8::EpiRes E{H, H, WSP(bf16, WS_AB), nullptr, WSP(float, WS_SSP)};
      pg8::gemm_phase<pg8::EpiRes, pg8::StaticOrder, true, true>(lds, g, S, E); }
    grid.sync();
    if (PH(6)) { pg8::Gemm g{WSP(bf16, WS_AB), WSP(bf16, WS_PW1), M, INW, DM}; pg8::StaticOrder S; S.init(M, INW, G, bx); pg8::EpiGlu E{WSP(bf16, WS_G), WSP(float, WS_SSP), args.in[16]};
      pg8::gemm_phase<pg8::EpiGlu, pg8::StaticOrder, true, true>(lds, g, S, E); }
    grid.sync();
    if (PH(7)) conv_phase(lds, WSP(bf16, WS_G), WSP(bf16, WS_Y), args.in[17], args.in[18], args.in[19], args.in[20], vcu, G);
    grid.sync();
    if (PH(8)) { pg8::Gemm g{WSP(bf16, WS_Y), WSP(bf16, WS_PW2), M, DM, DM}; pg8::StaticOrder S; S.init(M, DM, G, bx); pg8::EpiRes E{H, H, WSP(bf16, WS_AB), args.in[22], WSP(float, WS_SSP)};
      pg8::gemm_phase<pg8::EpiRes, pg8::StaticOrder, true, true>(lds, g, S, E); }
    grid.sync();
    if (PH(9)) { pg8::Gemm g{WSP(bf16, WS_AB), WSP(bf16, WS_WUP) + (size_t)DFF * DM, M, DFF, DM}; pg8::StaticOrder S; S.init(M, DFF, G, bx); pg8::EpiUp E{WSP(bf16, WS_HID), WSP(float, WS_SSP)};
      pg8::gemm_phase<pg8::EpiUp, pg8::StaticOrder, true, true>(lds, g, S, E); }
    grid.sync();
    if (PH(10)) { pg8::Gemm g{WSP(bf16, WS_HID), WSP(bf16, WS_WDN) + (size_t)DM * DFF, M, DM, DFF}; pg8::StaticOrder S; S.init(M, DM, G, bx); pg8::EpiRes E{H, H, WSP(bf16, WS_AB), nullptr, WSP(float, WS_SSP)};
      pg8::gemm_phase<pg8::EpiRes, pg8::StaticOrder, true, true>(lds, g, S, E); }
    grid.sync();
    if (PH(11)) { const int t_ = opaque_tid(); final_phase(H, WSP(float, WS_SSP), args.in[5], vcu, G, __builtin_amdgcn_readfirstlane(t_ >> 6), t_ & 63); }
}

extern "C" void kernel_launch(void* const* d_in, const int* in_sizes, int n_in, void* d_out, int out_size, void* d_ws, size_t ws_size, hipStream_t stream) {
    static int grid = 0;
    if (grid == 0) {
        if (n_in != 23 || in_sizes[0] != M * DM || out_size != M * DM || ws_size < WS_END) { fprintf(stderr, "kernel_launch: unexpected shapes (n_in %d, in0 %d, out %d, ws %zu)\n", n_in, n_in > 0 ? in_sizes[0] : -1, out_size, ws_size); grid = -1; return; }
        int dev = 0, cus = 0, per_cu = 0;
        if (hipGetDevice(&dev) != hipSuccess || hipDeviceGetAttribute(&cus, hipDeviceAttributeMultiprocessorCount, dev) != hipSuccess) { grid = -1; return; }
        if (hipFuncSetAttribute((const void*)fwd_megakernel, hipFuncAttributeMaxDynamicSharedMemorySize, LDS_BYTES) != hipSuccess) { fprintf(stderr, "kernel_launch: hipFuncSetAttribute failed\n"); grid = -1; return; }
        if (hipOccupancyMaxActiveBlocksPerMultiprocessor(&per_cu, (const void*)fwd_megakernel, NWAVES * 64, LDS_BYTES) != hipSuccess || per_cu < 1) { fprintf(stderr, "kernel_launch: occupancy query says %d\n", per_cu); per_cu = 1; }
        (void)hipGetLastError();
        grid = cus * 1;
        fprintf(stderr, "kernel_launch: grid %d (cus %d, occupancy %d)\n", grid, cus, per_cu);
    }
    if (grid < 0) return;
    Args a{};
    for (int i = 0; i < 23; ++i) a.in[i] = (const float*)d_in[i];
    a.out = (float*)d_out; a.ws = (unsigned char*)d_ws;
    for (int i = 0; i < 8; ++i) a.invf[i] = (float)std::pow(500000.0, -(double)i / 8.0);
    void* kargs[] = {&a};
    hipError_t e = hipLaunchCooperativeKernel((const void*)fwd_megakernel, dim3(grid), dim3(NWAVES * 64), kargs, LDS_BYTES, stream);
    if (e != hipSuccess) fprintf(stderr, "kernel_launch: cooperative launch failed: %s (grid %d)\n", hipGetErrorString(e), grid);
}
```

```cpp
#include <hip/hip_runtime.h>
#include <hip/hip_cooperative_groups.h>
#include <cstdio>
#include <cstdint>
#include <cmath>
namespace cg = cooperative_groups;

__device__ __forceinline__ int opaque_tid() { int t = threadIdx.x; asm volatile("" : "+v"(t)); return t; }

namespace pg8 {
#define PG8_LAS __attribute__((address_space(3)))
typedef unsigned short bf16_t;
typedef short bf16x8 __attribute__((ext_vector_type(8)));
typedef float f32x4 __attribute__((ext_vector_type(4)));
typedef unsigned u32x4 __attribute__((ext_vector_type(4)));
constexpr int BM = 256, BK = 64, HALF = 128, HTB = HALF * BK * 2  , STAGE_BYTES = 8 * HTB, NXCD = 8, WGM = 8;

__host__ __device__ __forceinline__ int lds_byte(int r, int c) { const int st = (r >> 4) * 2 + (c >> 5), rr = r & 15, cc = c & 31, ob = rr * 64 + cc * 2; return st * 1024 + (ob ^ (((ob >> 9) & 1) << 5)); }
__host__ __device__ __forceinline__ void stage_rc(int b, int& R, int& C) { const int st = b / 1024, sb = b % 1024, swz = sb ^ (((sb >> 9) & 1) << 5); R = (st >> 1) * 16 + swz / 64; C = (st & 1) * 32 + (swz % 64) / 2; }
__host__ __device__ __forceinline__ int perm32(int rho) { const int n = rho >> 4, i = rho & 15; return 8 * (i >> 2) + 4 * n + (i & 3); }

struct Unit { int pm, pn; };
struct Gemm { const bf16_t* A; const bf16_t* Bt; int M, N, K; };

struct StaticOrder {
    int nM, nN, nwg, G, c;
    __host__ __device__ void init(int M, int N, int G_, int c_) { nM = M / BM; nN = N / BM; nwg = nM * nN; G = G_; c = c_; }
    __host__ __device__ bool next(int i, Unit& u) const {
        const long L = (long)i * G + c; if (L >= nwg) return false;
        int wgid = (int)L; { const int q = nwg / NXCD, r = nwg % NXCD, xcd = wgid % NXCD, off = wgid / NXCD; wgid = (xcd < r ? xcd * (q + 1) : r * (q + 1) + (xcd - r) * q) + off; }
        const int nig = WGM * nN, gid = wgid / nig, fm = gid * WGM, gsz = (nM - fm) < WGM ? (nM - fm) : WGM;
        u.pm = fm + ((wgid % nig) % gsz); u.pn = (wgid % nig) / gsz; return true;
    }
    __device__ __forceinline__ void a_ready(const Unit&) const {}
    __device__ __forceinline__ void done(const Unit&) const {}
};

typedef float f32x2v __attribute__((ext_vector_type(2))); typedef __bf16 bf16x2v __attribute__((ext_vector_type(2)));
__device__ __forceinline__ unsigned cvt_pk_bf16(float lo, float hi) { f32x2v v = {lo, hi}; bf16x2v b = __builtin_convertvector(v, bf16x2v); return __builtin_bit_cast(unsigned, b); }
__device__ __forceinline__ u32x4 pack8(const f32x4& v0, const f32x4& v1) { u32x4 w; w.x = cvt_pk_bf16(v0[0], v0[1]); w.y = cvt_pk_bf16(v0[2], v0[3]); w.z = cvt_pk_bf16(v1[0], v1[1]); w.w = cvt_pk_bf16(v1[2], v1[3]); return w; }

constexpr int MROWS = 32768;
constexpr float C2 = 0.125f * 1.4426950408889634f;
constexpr float RMS_EPS = 1e-6f;

__device__ __forceinline__ float row_inv_rms(const float* ssp, int row) {
    const f32x4* p = (const f32x4*)(ssp + (size_t)row * 16);
    const f32x4 a = p[0], b = p[1], c = p[2], d = p[3];
    const float s = ((a[0] + a[1]) + (a[2] + a[3])) + ((b[0] + b[1]) + (b[2] + b[3])) + ((c[0] + c[1]) + (c[2] + c[3])) + ((d[0] + d[1]) + (d[2] + d[3]));
    return 1.0f / sqrtf(s * (1.0f / 1024.0f) + RMS_EPS);
}

struct EpiIn {
    static constexpr bool PERM = true, AFTER_DRAIN = false;
    bf16_t* Z; const float* rope;
    __device__ __forceinline__ void operator()(const f32x4 (&acc)[2][2][4][2], const Unit& u, int wr, int wc, int fr, int fq) const {
        const int sec = u.pn >> 1;
        bf16_t* base = Z + (size_t)sec * MROWS * 512;
        const int cs0 = (u.pn & 1) * 256 + wc * 32 + 8 * fq;
        const int row0 = u.pm * BM + wr * 64 + fr;
        const bool ropew = (sec == 1 || sec == 2) && ((wc & 1) == 0);
        const float sc = (sec == 1) ? C2 : 1.0f;
#pragma unroll
        for (int ai = 0; ai < 2; ++ai)
#pragma unroll
            for (int m = 0; m < 4; ++m) {
                const int row = row0 + ai * HALF + m * 16; const int pos = row & 8191;
                f32x4 c0 = {1.f, 1.f, 1.f, 1.f}, c1 = c0, s0 = {0.f, 0.f, 0.f, 0.f}, s1 = s0;
                if (ropew) { const f32x4* cp = (const f32x4*)(rope + (size_t)pos * 8); const f32x4* sp = (const f32x4*)(rope + 65536 + (size_t)pos * 8); c0 = cp[0]; c1 = cp[1]; s0 = sp[0]; s1 = sp[1]; }
#pragma unroll
                for (int bj = 0; bj < 2; ++bj) {
                    f32x4 v0 = acc[ai][bj][m][0], v1 = acc[ai][bj][m][1];
                    if (ropew) {
                        f32x4 p0, p1;
#pragma unroll
                        for (int e = 0; e < 4; ++e) { p0[e] = __shfl_xor(v0[e], 16); p1[e] = __shfl_xor(v1[e], 16); }
                        if (fq == 0) { v0 = v0 * c0 - p0 * s0; v1 = v1 * c1 - p1 * s1; }
                        else if (fq == 1) { v0 = v0 * c0 + p0 * s0; v1 = v1 * c1 + p1 * s1; }
                    }
                    v0 = v0 * sc; v1 = v1 * sc;
                    *(u32x4*)(base + (size_t)row * 512 + cs0 + bj * HALF) = pack8(v0, v1);
                }
            }
    }
};

struct EpiRes {
    static constexpr bool PERM = true, AFTER_DRAIN = false;
    const float* R; float* H; bf16_t* HB; const float* bias; float* ssp;
    __device__ __forceinline__ void operator()(const f32x4 (&acc)[2][2][4][2], const Unit& u, int wr, int wc, int fr, int fq) const {
        const int row0 = u.pm * BM + wr * 64 + fr, col0 = u.pn * BM + wc * 32 + 8 * fq;
        f32x4 bv[2][2];
#pragma unroll
        for (int bj = 0; bj < 2; ++bj)
#pragma unroll
            for (int n = 0; n < 2; ++n) bv[bj][n] = bias ? *(const f32x4*)(bias + col0 + bj * HALF + 4 * n) : (f32x4){0.f, 0.f, 0.f, 0.f};
#pragma unroll
        for (int ai = 0; ai < 2; ++ai)
#pragma unroll
            for (int m = 0; m < 4; ++m) {
                const int row = row0 + ai * HALF + m * 16; float ss = 0.f;
#pragma unroll
                for (int bj = 0; bj < 2; ++bj) {
                    const size_t off = (size_t)row * 1024 + col0 + bj * HALF;
                    const f32x4 r0 = *(const f32x4*)(R + off), r1 = *(const f32x4*)(R + off + 4);
                    const f32x4 v0 = acc[ai][bj][m][0] + bv[bj][0] + r0, v1 = acc[ai][bj][m][1] + bv[bj][1] + r1;
                    *(f32x4*)(H + off) = v0; *(f32x4*)(H + off + 4) = v1;
                    *(u32x4*)(HB + off) = pack8(v0, v1);
                    ss += (v0[0] * v0[0] + v0[1] * v0[1]) + (v0[2] * v0[2] + v0[3] * v0[3]) + (v1[0] * v1[0] + v1[1] * v1[1]) + (v1[2] * v1[2] + v1[3] * v1[3]);
                }
                ss += __shfl_xor(ss, 16); ss += __shfl_xor(ss, 32);
                if (fq == 0) ssp[(size_t)row * 16 + u.pn * 4 + wc] = ss;
                asm volatile("" ::: "memory");
            }
    }
};

struct EpiUp {
    static constexpr bool PERM = true, AFTER_DRAIN = false;
    bf16_t* O; const float* ssp;
    __device__ __forceinline__ void operator()(const f32x4 (&acc)[2][2][4][2], const Unit& u, int wr, int wc, int fr, int fq) const {
        const int row0 = u.pm * BM + wr * 64 + fr, col0 = u.pn * BM + wc * 32 + 8 * fq;
#pragma unroll
        for (int ai = 0; ai < 2; ++ai)
#pragma unroll
            for (int m = 0; m < 4; ++m) {
                const int row = row0 + ai * HALF + m * 16; const float s = row_inv_rms(ssp, row);
#pragma unroll
                for (int bj = 0; bj < 2; ++bj) {
                    f32x4 v0 = acc[ai][bj][m][0] * s, v1 = acc[ai][bj][m][1] * s;
#pragma unroll
                    for (int e = 0; e < 4; ++e) { const float a = fmaxf(v0[e], 0.f), b = fmaxf(v1[e], 0.f); v0[e] = a * a; v1[e] = b * b; }
                    *(u32x4*)(O + (size_t)row * 4096 + col0 + bj * HALF) = pack8(v0, v1);
                }
                asm volatile("" ::: "memory");
            }
    }
};

struct EpiGlu {
    static constexpr bool PERM = true, AFTER_DRAIN = false;
    bf16_t* O; const float* ssp; const float* bias;
    __device__ __forceinline__ void operator()(const f32x4 (&acc)[2][2][4][2], const Unit& u, int wr, int wc, int fr, int fq) const {
        const int row0 = u.pm * BM + wr * 64 + fr, col0 = u.pn * HALF + wc * 32 + 8 * fq;
        const f32x4 bv0 = *(const f32x4*)(bias + col0), bv1 = *(const f32x4*)(bias + col0 + 4), bg0 = *(const f32x4*)(bias + 1024 + col0), bg1 = *(const f32x4*)(bias + 1024 + col0 + 4);
#pragma unroll
        for (int ai = 0; ai < 2; ++ai)
#pragma unroll
            for (int m = 0; m < 4; ++m) {
                const int row = row0 + ai * HALF + m * 16; const float s = row_inv_rms(ssp, row);
                f32x4 a0 = acc[ai][0][m][0] * s + bv0, a1 = acc[ai][0][m][1] * s + bv1;
                const f32x4 g0 = acc[ai][1][m][0] * s + bg0, g1 = acc[ai][1][m][1] * s + bg1;
#pragma unroll
                for (int e = 0; e < 4; ++e) {
                    a0[e] = a0[e] * __builtin_amdgcn_rcpf(1.0f + __builtin_amdgcn_exp2f(-1.4426950408889634f * g0[e]));
                    a1[e] = a1[e] * __builtin_amdgcn_rcpf(1.0f + __builtin_amdgcn_exp2f(-1.4426950408889634f * g1[e]));
                }
                *(u32x4*)(O + (size_t)row * 1024 + col0) = pack8(a0, a1);
                asm volatile("" ::: "memory");
            }
    }
};

template <class Epi, class Sched, bool ALIGN_EPI = false, bool SP2 = false>
__device__ __forceinline__ void gemm_phase(PG8_LAS unsigned char* lds, const Gemm g, const Sched& S, const Epi& E) {
    const int tid = opaque_tid(), wid = __builtin_amdgcn_readfirstlane(tid >> 6), lane = tid & 63, wr = wid >> 2, wc = wid & 3, fr = lane & 15, fq = lane >> 4;
    const int K = g.K, nt = K / BK;
    unsigned voffA[2], voffB[2];
#pragma unroll
    for (int i = 0; i < 2; ++i) { int R, C; stage_rc(tid * 16 + i * 8192, R, C); const int Rb = Epi::PERM ? ((R & ~31) + perm32(R & 31)) : R;
        voffA[i] = (unsigned)(R * K + C) * 2u; voffB[i] = (unsigned)(Rb * K + C) * 2u; }
    const size_t kstep = (size_t)(BK * 2);
    const size_t hstep = (size_t)HALF * K * 2;
    const size_t tstep = 2 * hstep;
    const unsigned ldsw = (unsigned)wid * 1024u;
    const int aoff = lds_byte(wr * 64 + fr, fq * 8), boff = lds_byte(wc * 32 + fr, fq * 8);
#define PG8_SA(b, h) (((b) * 2 + (h)) * HTB)
#define PG8_SB(b, h) ((4 + (b) * 2 + (h)) * HTB)
#define PG8_STAGE(bufoff, gbase, voff) do { _Pragma("unroll") for (int _i = 0; _i < 2; ++_i) \
        __builtin_amdgcn_global_load_lds((const unsigned*)((const char*)(gbase) + (voff)[_i]), (PG8_LAS unsigned*)(lds + (bufoff) + ldsw + _i * 8192), 16, 0, 0); } while (0)
#define PG8_LDA(dst, b, h) do { _Pragma("unroll") for (int m = 0; m < 4; ++m) _Pragma("unroll") for (int k = 0; k < 2; ++k) dst[m][k] = *(const PG8_LAS bf16x8*)(lds + PG8_SA(b, h) + aoff + m * 2048 + k * 1024); } while (0)
#define PG8_LDB(dst, b, h) do { _Pragma("unroll") for (int n = 0; n < 2; ++n) _Pragma("unroll") for (int k = 0; k < 2; ++k) dst[n][k] = *(const PG8_LAS bf16x8*)(lds + PG8_SB(b, h) + boff + n * 2048 + k * 1024); } while (0)
#define PG8_MMA(ai, bj, At, Bt) do { __builtin_amdgcn_s_setprio(1); _Pragma("unroll") for (int m = 0; m < 4; ++m) _Pragma("unroll") for (int n = 0; n < 2; ++n) _Pragma("unroll") for (int k = 0; k < 2; ++k) \
        acc[ai][bj][m][n] = __builtin_amdgcn_mfma_f32_16x16x32_bf16(Bt[n][k], At[m][k], acc[ai][bj][m][n], 0, 0, 0); __builtin_amdgcn_s_setprio(0); } while (0)
#define PG8_WAIT_V(n) asm volatile("s_waitcnt vmcnt(" #n ")" ::: "memory")
#define PG8_WAIT_L(n) asm volatile("s_waitcnt lgkmcnt(" #n ")" ::: "memory")
#define PG8_BAR __builtin_amdgcn_s_barrier()
#define PG8_SCHED __builtin_amdgcn_sched_barrier(0)
    Unit cur, nxt; int ui = 0;
    if (!S.next(0, cur)) return;
    f32x4 acc[2][2][4][2];
#pragma unroll
    for (int a = 0; a < 2; ++a)
#pragma unroll
        for (int b = 0; b < 2; ++b)
#pragma unroll
            for (int m = 0; m < 4; ++m)
#pragma unroll
                for (int n = 0; n < 2; ++n) acc[a][b][m][n] = (f32x4){0.f, 0.f, 0.f, 0.f};
    bf16x8 At[4][2], B0[2][2], B1[2][2];
    const char* cA = (const char*)g.A + (size_t)cur.pm * tstep; const char* cB = (const char*)g.Bt + (size_t)cur.pn * tstep;
    S.a_ready(cur);
    if constexpr (SP2) {
        PG8_STAGE(PG8_SB(0, 0), cB, voffB); PG8_STAGE(PG8_SB(0, 1), cB + hstep, voffB); PG8_STAGE(PG8_SA(0, 0), cA, voffA); PG8_STAGE(PG8_SA(0, 1), cA + hstep, voffA);
        if (wr == 1) PG8_BAR;
        PG8_WAIT_V(2); PG8_BAR;
        PG8_STAGE(PG8_SB(1, 0), cB + kstep, voffB); PG8_STAGE(PG8_SA(1, 0), cA + kstep, voffA); PG8_STAGE(PG8_SB(1, 1), cB + hstep + kstep, voffB);
        PG8_WAIT_V(6); PG8_BAR;
    } else {
        PG8_STAGE(PG8_SB(0, 0), cB, voffB); PG8_STAGE(PG8_SA(0, 0), cA, voffA); PG8_STAGE(PG8_SB(0, 1), cB + hstep, voffB); PG8_STAGE(PG8_SA(0, 1), cA + hstep, voffA);
        if (wr == 1) PG8_BAR;
        PG8_WAIT_V(4); PG8_BAR;
        PG8_STAGE(PG8_SB(1, 0), cB + kstep, voffB); PG8_STAGE(PG8_SA(1, 0), cA + kstep, voffA); PG8_STAGE(PG8_SB(1, 1), cB + hstep + kstep, voffB);
        PG8_WAIT_V(6); PG8_BAR;
    }
    for (;;) {
        const bool has_next = S.next(ui + 1, nxt);
        const char* nA = has_next ? (const char*)g.A + (size_t)nxt.pm * tstep : cA; const char* nB = has_next ? (const char*)g.Bt + (size_t)nxt.pn * tstep : cB;
        for (int t = 0; t < nt; t += 2) {
            const bool last = (t == nt - 2);
            const char* a1 = cA + (size_t)(t + 1) * kstep;
            const char* a2 = last ? nA : cA + (size_t)(t + 2) * kstep; const char* b2 = last ? nB : cB + (size_t)(t + 2) * kstep;
            const char* a3 = a2 + kstep; const char* b3 = b2 + kstep;
            if (last && has_next) S.a_ready(nxt);
            if constexpr (SP2) {
            PG8_LDB(B0, 0, 0); PG8_LDB(B1, 0, 1); PG8_SCHED; PG8_LDA(At, 0, 0); PG8_STAGE(PG8_SA(1, 1), a1 + hstep, voffA);
            PG8_WAIT_V(8); PG8_WAIT_L(0); PG8_BAR; PG8_MMA(0, 0, At, B0); PG8_MMA(0, 1, At, B1); PG8_BAR; PG8_SCHED;
            PG8_LDA(At, 0, 1); PG8_STAGE(PG8_SB(0, 0), b2, voffB); PG8_STAGE(PG8_SB(0, 1), b2 + hstep, voffB); PG8_STAGE(PG8_SA(0, 0), a2, voffA);
            PG8_WAIT_V(8); PG8_WAIT_L(0); PG8_BAR; PG8_MMA(1, 0, At, B0); PG8_MMA(1, 1, At, B1); PG8_BAR; PG8_SCHED;
            PG8_LDB(B0, 1, 0); PG8_LDB(B1, 1, 1); PG8_SCHED; PG8_LDA(At, 1, 0); PG8_STAGE(PG8_SA(0, 1), a2 + hstep, voffA);
            PG8_WAIT_V(8); PG8_WAIT_L(0); PG8_BAR; PG8_MMA(0, 0, At, B0); PG8_MMA(0, 1, At, B1); PG8_BAR; PG8_SCHED;
            PG8_LDA(At, 1, 1); PG8_STAGE(PG8_SB(1, 0), b3, voffB); PG8_STAGE(PG8_SB(1, 1), b3 + hstep, voffB); PG8_STAGE(PG8_SA(1, 0), a3, voffA);
            PG8_WAIT_V(8); PG8_WAIT_L(0); PG8_BAR; PG8_MMA(1, 0, At, B0); PG8_MMA(1, 1, At, B1); PG8_BAR; PG8_SCHED;
            } else {
            PG8_LDB(B0, 0, 0); PG8_SCHED; PG8_LDA(At, 0, 0); PG8_STAGE(PG8_SA(1, 1), a1 + hstep, voffA);
            PG8_WAIT_L(8); PG8_BAR; PG8_WAIT_L(0); PG8_MMA(0, 0, At, B0); PG8_BAR; PG8_SCHED;
            PG8_LDB(B1, 0, 1); PG8_STAGE(PG8_SB(0, 0), b2, voffB);
            PG8_BAR; PG8_WAIT_L(0); PG8_MMA(0, 1, At, B1); PG8_BAR;
            PG8_LDA(At, 0, 1); PG8_STAGE(PG8_SA(0, 0), a2, voffA);
            PG8_BAR; PG8_WAIT_L(0); PG8_MMA(1, 0, At, B0); PG8_BAR; PG8_SCHED;
            PG8_STAGE(PG8_SB(0, 1), b2 + hstep, voffB);
            PG8_WAIT_V(6); PG8_BAR; PG8_MMA(1, 1, At, B1); PG8_BAR;
            PG8_LDB(B0, 1, 0); PG8_SCHED; PG8_LDA(At, 1, 0); PG8_STAGE(PG8_SA(0, 1), a2 + hstep, voffA);
            PG8_WAIT_L(8); PG8_BAR; PG8_WAIT_L(0); PG8_MMA(0, 0, At, B0); PG8_BAR; PG8_SCHED;
            PG8_LDB(B1, 1, 1); PG8_STAGE(PG8_SB(1, 0), b3, voffB);
            PG8_BAR; PG8_WAIT_L(0); PG8_MMA(0, 1, At, B1); PG8_BAR;
            PG8_LDA(At, 1, 1); PG8_STAGE(PG8_SA(1, 0), a3, voffA);
            PG8_BAR; PG8_WAIT_L(0); PG8_MMA(1, 0, At, B0); PG8_BAR; PG8_SCHED;
            PG8_STAGE(PG8_SB(1, 1), b3 + hstep, voffB);
            PG8_WAIT_V(6); PG8_BAR; PG8_MMA(1, 1, At, B1); PG8_BAR;
            }
        }
        if constexpr (ALIGN_EPI) { if (wr == 0) PG8_BAR; }
        if constexpr (!Epi::AFTER_DRAIN) { E(acc, cur, wr, wc, fr, fq); S.done(cur); }
        if (!has_next) break;
#pragma unroll
        for (int a = 0; a < 2; ++a)
#pragma unroll
            for (int b = 0; b < 2; ++b)
#pragma unroll
                for (int m = 0; m < 4; ++m)
#pragma unroll
                    for (int n = 0; n < 2; ++n) acc[a][b][m][n] = (f32x4){0.f, 0.f, 0.f, 0.f};
        cur = nxt; cA = nA; cB = nB; ++ui;
        if constexpr (ALIGN_EPI) { if (wr == 1) PG8_BAR; }
    }
    PG8_WAIT_V(0);
    if constexpr (!ALIGN_EPI) { if (wr == 0) PG8_BAR; }
    PG8_BAR;
    if constexpr (Epi::AFTER_DRAIN) { E.fused(acc, cur, wr, wc, fr, fq, lds, wid, lane); S.done(cur); }
#undef PG8_SA
#undef PG8_SB
#undef PG8_STAGE
#undef PG8_LDA
#undef PG8_LDB
#undef PG8_MMA
#undef PG8_WAIT_V
#undef PG8_WAIT_L
#undef PG8_BAR
#undef PG8_SCHED
}
}

#define LAS __attribute__((address_space(3)))
typedef unsigned short bf16;
typedef unsigned u32x4 __attribute__((ext_vector_type(4)));
typedef unsigned u32x2 __attribute__((ext_vector_type(2)));
typedef float f32x4 __attribute__((ext_vector_type(4)));
typedef float f32x2 __attribute__((ext_vector_type(2)));
typedef float f32x16 __attribute__((ext_vector_type(16)));
typedef short bf16x8 __attribute__((ext_vector_type(8)));
typedef short s16x4 __attribute__((ext_vector_type(4)));
#define LDS_WAIT() asm volatile("s_waitcnt lgkmcnt(0)" ::: "memory")

constexpr int NWAVES = 8;
constexpr int BATCH = 4, SEQ = 8192, DM = 1024, M = BATCH * SEQ, DFF = 4096, INW = 2048;
constexpr int LDS_BYTES = 147456, MISC_OFF = 147200;
constexpr size_t MiB = 1u << 20;
constexpr size_t WS_CTL = 0;
constexpr size_t WS_WIN = 1 * MiB;
constexpr size_t WS_WCAT = 5 * MiB;
constexpr size_t WS_WUP = 7 * MiB;
constexpr size_t WS_WDN = 23 * MiB;
constexpr size_t WS_PW1 = 39 * MiB;
constexpr size_t WS_PW2 = 43 * MiB;
constexpr size_t WS_ROPE = 45 * MiB;
constexpr size_t WS_SSP = 46 * MiB;
constexpr size_t WS_AB = 48 * MiB;
constexpr size_t WS_BIG = 112 * MiB;
constexpr size_t WS_Z = WS_BIG, WS_CAT = WS_BIG + 128 * MiB, WS_HID = WS_BIG, WS_G = WS_BIG, WS_Y = WS_BIG + 64 * MiB;
constexpr size_t WS_END = WS_BIG + 256 * MiB;

__device__ __forceinline__ unsigned pk2(float lo, float hi) { return pg8::cvt_pk_bf16(lo, hi); }
__device__ __forceinline__ float bflo(unsigned v) { return __uint_as_float(v << 16); }
__device__ __forceinline__ float bfhi(unsigned v) { return __uint_as_float(v & 0xffff0000u); }
__device__ __forceinline__ float wave_sum(float v) {
#pragma unroll
    for (int o = 1; o < 64; o <<= 1) v += __shfl_xor(v, o);
    return v;
}

__device__ __forceinline__ void tr_item(const float* W, int ldw, int k0, int n0, const float* gain, bf16* WT, int ldt, int drow0, LAS float* scr, int lane) {
#pragma unroll 8
    for (int i = 0; i < 32; ++i) { const int kk = 2 * i + (lane >> 5); const float g = gain ? gain[k0 + kk] : 1.0f; scr[kk * 33 + (lane & 31)] = W[(size_t)(k0 + kk) * ldw + n0 + (lane & 31)] * g; }
    LDS_WAIT();
    const int c = lane & 7;
#pragma unroll
    for (int j = 0; j < 4; ++j) { const int n = (lane >> 3) + 8 * j; const LAS float* s = scr + (8 * c) * 33 + n;
        u32x4 o; o.x = pk2(s[0 * 33], s[1 * 33]); o.y = pk2(s[2 * 33], s[3 * 33]); o.z = pk2(s[4 * 33], s[5 * 33]); o.w = pk2(s[6 * 33], s[7 * 33]);
        *(u32x4*)(WT + (size_t)(drow0 + n) * ldt + k0 + 8 * c) = o; }
    LDS_WAIT();
}
__device__ __forceinline__ void tr_matrix_item(const float* W, int K, int N, int kbase, const float* gain, bf16* WT, int ldt, int item, bool glu, LAS float* scr, int lane) {
    const int nblk = N / 32, kb = item / nblk, nb = item % nblk; const int k0 = kbase + 64 * kb, n0 = 32 * nb;
    int drow0 = n0;
    if (glu) { const int half = n0 >= 1024 ? 1 : 0, j = n0 - half * 1024; drow0 = 256 * (j >> 7) + 128 * half + (j & 127); }
    tr_item(W, N, k0, n0, gain, WT, ldt, drow0, scr, lane);
}

struct Args {
    const float* in[23]; float* out; unsigned char* ws; float invf[8];
};

__device__ __forceinline__ void prologue(const Args& a, LAS unsigned char* lds, int vcu, int G, int wave, int lane) {
    unsigned char* ws = a.ws;
    LAS float* scr = (LAS float*)(lds + wave * 16384);
    const int gw = vcu * NWAVES + wave, NGW = G * NWAVES;
    const float* x = a.in[0]; const float* mix_norm = a.in[1]; const float* mlp_norm = a.in[2]; const float* w_up = a.in[3]; const float* w_down = a.in[4];
    const float* w_in = a.in[6]; const float* pool_w = a.in[7]; const float* pool_scale = a.in[8]; const float* w_out = a.in[14];
    const float* pw1 = a.in[15]; const float* pw2 = a.in[21];
    bf16* WIN = (bf16*)(ws + WS_WIN); bf16* WCAT = (bf16*)(ws + WS_WCAT); bf16* WUP = (bf16*)(ws + WS_WUP); bf16* WDN = (bf16*)(ws + WS_WDN);
    bf16* PW1 = (bf16*)(ws + WS_PW1); bf16* PW2 = (bf16*)(ws + WS_PW2);
    constexpr int I_IN = 16 * 64, I_OUT = 8 * 32, I_UP = 16 * 128, I_DN = 64 * 32, I_PW1 = 16 * 64, I_PW2 = 16 * 32;
    constexpr int NITEMS = I_IN + I_OUT + 2 * I_UP + 2 * I_DN + I_PW1 + I_PW2;
    for (int it = gw; it < NITEMS; it += NGW) {
        int r = it;
        if (r < I_IN) { tr_matrix_item(w_in, 1024, 2048, 0, nullptr, WIN, 1024, r, false, scr, lane); continue; } r -= I_IN;
        if (r < I_OUT) { tr_matrix_item(w_out, 512, 1024, 512, nullptr, WCAT, 1024, r, false, scr, lane); continue; } r -= I_OUT;
        if (r < I_UP) { tr_matrix_item(w_up, 1024, 4096, 0, mlp_norm, WUP, 1024, r, false, scr, lane); continue; } r -= I_UP;
        if (r < I_UP) { tr_matrix_item(w_up + (size_t)1024 * 4096, 1024, 4096, 0, mlp_norm + 1024, WUP + (size_t)4096 * 1024, 1024, r, false, scr, lane); continue; } r -= I_UP;
        if (r < I_DN) { tr_matrix_item(w_down, 4096, 1024, 0, nullptr, WDN, 4096, r, false, scr, lane); continue; } r -= I_DN;
        if (r < I_DN) { tr_matrix_item(w_down + (size_t)4096 * 1024, 4096, 1024, 0, nullptr, WDN + (size_t)1024 * 4096, 4096, r, false, scr, lane); continue; } r -= I_DN;
        if (r < I_PW1) { tr_matrix_item(pw1, 1024, 2048, 0, mix_norm + 1024, PW1, 1024, r, true, scr, lane); continue; } r -= I_PW1;
        tr_matrix_item(pw2, 1024, 1024, 0, nullptr, PW2, 1024, r, false, scr, lane);
    }
    for (int it = gw; it < 16 * 64; it += NGW) {
        const int nb = it & 15, kb = it >> 4; const int n = nb * 64 + lane, k0 = kb * 8, g = k0 >> 7;
        float acc8[8];
#pragma unroll
        for (int i = 0; i < 8; ++i) acc8[i] = 0.f;
        for (int d = 0; d < 128; ++d) {
            const float wv = w_out[(size_t)(g * 128 + d) * 1024 + n] * pool_scale[g * 128 + d];
#pragma unroll
            for (int i = 0; i < 8; ++i) acc8[i] += pool_w[(size_t)(k0 + i) * 128 + d] * wv;
        }
        u32x4 o; o.x = pk2(acc8[0], acc8[1]); o.y = pk2(acc8[2], acc8[3]); o.z = pk2(acc8[4], acc8[5]); o.w = pk2(acc8[6], acc8[7]);
        *(u32x4*)(WCAT + (size_t)n * 1024 + k0) = o;
    }
    {
        float* rope = (float*)(ws + WS_ROPE);
        const int gt = (vcu * NWAVES + wave) * 64 + lane, NGT = NGW * 64;
        for (int idx = gt; idx < 8192 * 8; idx += NGT) {
            const int pos = idx >> 3, i = idx & 7;
            const float angf = (float)pos * a.invf[i];
            const double ang = (double)angf;
            const double n = __builtin_rint(ang * 0.15915494309189535);
            const double y = ang - n * 6.283185307179586476925;
            const double y2 = y * y;
            double sp = 1.0, cp = 1.0;
#pragma unroll
            for (int k = 13; k >= 1; --k) { sp = 1.0 - sp * y2 / (double)((2 * k) * (2 * k + 1)); cp = 1.0 - cp * y2 / (double)((2 * k - 1) * (2 * k)); }
            rope[idx] = (float)cp; rope[65536 + idx] = (float)(y * sp);
        }
    }
    {
        bf16* XN = (bf16*)(ws + WS_AB);
        f32x4 gv[4];
#pragma unroll
        for (int j = 0; j < 4; ++j) gv[j] = ((const f32x4*)mix_norm)[lane + 64 * j];
        for (int m = gw; m < M; m += NGW) {
            const f32x4* xr = (const f32x4*)(x + (size_t)m * DM) + lane;
            f32x4 v[4]; float s = 0.f;
#pragma unroll
            for (int j = 0; j < 4; ++j) { v[j] = xr[64 * j]; s += (v[j][0] * v[j][0] + v[j][1] * v[j][1]) + (v[j][2] * v[j][2] + v[j][3] * v[j][3]); }
            const float inv = 1.0f / sqrtf(wave_sum(s) * (1.0f / DM) + 1e-6f);
            u32x2* o8 = (u32x2*)(XN + (size_t)m * DM) + lane;
#pragma unroll
            for (int j = 0; j < 4; ++j) { u32x2 o; o.x = pk2(v[j][0] * inv * gv[j][0], v[j][1] * inv * gv[j][1]); o.y = pk2(v[j][2] * inv * gv[j][2], v[j][3] * inv * gv[j][3]); o8[64 * j] = o; }
        }
    }
}

__device__ __forceinline__ void pool_phase(const bf16* U, bf16* CAT, int vcu, int G, int tid) {
    const int gt = vcu * (NWAVES * 64) + tid, NGT = G * NWAVES * 64;
    for (int it = gt; it < M * 64; it += NGT) {
        const int row = it >> 6, c8 = it & 63; const int t = row & (SEQ - 1); const int g = c8 >> 4; const int w = 2 << g;
        const int cnt = (t + 1 < w) ? (t + 1) : w;
        float s[8];
#pragma unroll
        for (int e = 0; e < 8; ++e) s[e] = 0.f;
        float tok[8];
        for (int j = 0; j < cnt; ++j) {
            const u32x4 v = *(const u32x4*)(U + (size_t)(row - j) * 512 + c8 * 8);
            const float f[8] = {bflo(v.x), bfhi(v.x), bflo(v.y), bfhi(v.y), bflo(v.z), bfhi(v.z), bflo(v.w), bfhi(v.w)};
#pragma unroll
            for (int e = 0; e < 8; ++e) { s[e] += f[e]; if (j == 0) tok[e] = f[e]; }
        }
        const float ic = 1.0f / (float)cnt;
        u32x4 o; o.x = pk2(s[0] * ic - tok[0], s[1] * ic - tok[1]); o.y = pk2(s[2] * ic - tok[2], s[3] * ic - tok[3]);
        o.z = pk2(s[4] * ic - tok[4], s[5] * ic - tok[5]); o.w = pk2(s[6] * ic - tok[6], s[7] * ic - tok[7]);
        *(u32x4*)(CAT + (size_t)row * 1024 + c8 * 8) = o;
    }
}

namespace att {
constexpr int KBUF = 0, VBUF = 32768, XOFF = 65536, WSF = 131072;
__device__ __forceinline__ int crow(int r, int hi) { return (r & 3) + 8 * (r >> 2) + 4 * hi; }
__device__ __forceinline__ void glds16(const void* gsrc, unsigned lds_dst) { unsigned keep;
    asm volatile("s_mov_b32 %0, m0\n\ts_mov_b32 m0, %2\n\ts_nop 0\n\tglobal_load_lds_dwordx4 %1, off\n\ts_mov_b32 m0, %0" : "=&s"(keep) : "v"(gsrc), "s"(lds_dst) : "memory"); }
typedef short v4i16_t __attribute__((ext_vector_type(4)));
__device__ __forceinline__ s16x4 vtr(LAS const unsigned char* p) { return __builtin_bit_cast(s16x4, __builtin_amdgcn_ds_read_tr16_b64_v4i16((LAS v4i16_t*)p)); }
#define MX3(a, b, c) __builtin_fmaxf(__builtin_fmaxf((a), (b)), (c))
__device__ __forceinline__ float rowmax(const f32x16& p0, const f32x16& p1) {
    float a = MX3(p0[0], p0[1], p1[0]), b = MX3(p0[2], p0[3], p1[1]); a = MX3(a, p1[2], p1[3]);
#pragma unroll
    for (int r = 4; r < 16; r += 4) { a = MX3(a, p0[r], p0[r + 1]); b = MX3(b, p0[r + 2], p0[r + 3]); a = MX3(a, p1[r], p1[r + 1]); b = MX3(b, p1[r + 2], p1[r + 3]); }
    float m = __builtin_fmaxf(a, b); auto rr = __builtin_amdgcn_permlane32_swap(__float_as_uint(m), __float_as_uint(m), false, false);
    return __builtin_fmaxf(__uint_as_float(rr[0]), __uint_as_float(rr[1]));
}
#define MFMA32(a, b, c) __builtin_amdgcn_mfma_f32_32x32x16_bf16(a, b, c, 0, 0, 0)

__device__ __forceinline__ void attn_unit(int b, int h, int qb, const bf16* Q, const bf16* K, const bf16* V, bf16* CAT, const float* subln, float lam, LAS unsigned char* lds) {
    const int tid = opaque_tid(), lane = tid & 63, r32 = lane & 31, hi = lane >> 5; const int wid = __builtin_amdgcn_readfirstlane(tid >> 6);
    const int comp = wid >> 2, wq = wid & 3;
    const size_t rowbase = (size_t)b * SEQ; const int q0 = qb * 128; const int NT = (q0 + 128) / 64;
    const unsigned lds0 = (unsigned)(size_t)lds;
    LAS float* wsf = (LAS float*)(lds + WSF) + wid * 64;
    const bf16* Qw = Q + (rowbase + q0 + wq * 32 + r32) * 512 + h * 128 + comp * 64;
    bf16x8 qr[4];
#pragma unroll
    for (int d0 = 0; d0 < 4; ++d0) qr[d0] = *(const bf16x8*)(Qw + d0 * 16 + hi * 8);
    const bf16* ksrc[2]; const bf16* vsrc[2]; unsigned kdst[2], vdst[2];
#pragma unroll
    for (int i = 0; i < 2; ++i) { const int p = 2 * wid + i; const int kc = p >> 3, ch = p & 7, db = p >> 2, rg = p & 3;
        ksrc[i] = K + (rowbase + lane) * 512 + h * 128 + kc * 64 + ch * 8; kdst[i] = lds0 + KBUF + kc * 8192 + ch * 1024;
        vsrc[i] = V + (rowbase + 16 * rg + (lane >> 2)) * 512 + h * 128 + db * 32 + (lane & 3) * 8; vdst[i] = lds0 + VBUF + db * 4096 + rg * 1024; }
#define DMA_TILE(t, buf) do { _Pragma("unroll") for (int i_ = 0; i_ < 2; ++i_) { \
        glds16(ksrc[i_] + (size_t)(t) * 64 * 512, (unsigned)__builtin_amdgcn_readfirstlane(kdst[i_] + (buf) * 16384)); \
        glds16(vsrc[i_] + (size_t)(t) * 64 * 512, (unsigned)__builtin_amdgcn_readfirstlane(vdst[i_] + (buf) * 16384)); } } while (0)
    f32x16 o[4];
#pragma unroll
    for (int d0 = 0; d0 < 4; ++d0) o[d0] = f32x16{};
    float mref = -INFINITY, l = 0.f;
    const int qrel = wq * 32 + r32;
    asm volatile("s_waitcnt vmcnt(0)" ::: "memory");
    DMA_TILE(0, 0);
    for (int t = 0; t < NT; ++t) {
        const int buf = t & 1;
        if (t + 1 < NT) { DMA_TILE(t + 1, buf ^ 1); asm volatile("s_waitcnt vmcnt(4)" ::: "memory"); }
        else { asm volatile("s_waitcnt vmcnt(0)" ::: "memory"); }
        __builtin_amdgcn_s_barrier(); asm volatile("" ::: "memory");
        LAS const unsigned char* kp = lds + KBUF + buf * 16384 + comp * 8192 + hi * 1024 + r32 * 16;
        f32x16 p0 = f32x16{}, p1 = f32x16{};
#pragma unroll
        for (int d0 = 0; d0 < 4; ++d0) {
            const bf16x8 k0 = *(LAS const bf16x8*)(kp + d0 * 2048), k1 = *(LAS const bf16x8*)(kp + d0 * 2048 + 512);
            p0 = MFMA32(k0, qr[d0], p0); p1 = MFMA32(k1, qr[d0], p1);
        }
        if (t >= NT - 2) {
            const int kb = 64 * (t - (NT - 2)) + 4 * hi;
#pragma unroll
            for (int r = 0; r < 16; ++r) { const int kv = kb + (r & 3) + 8 * (r >> 2); if (kv > qrel) p0[r] = -INFINITY; if (kv + 32 > qrel) p1[r] = -INFINITY; }
        }
        const float rm = rowmax(p0, p1);
        if (__any(rm > mref + 8.0f)) {
            const float mnew = __builtin_fmaxf(mref, rm); const float alpha = __builtin_amdgcn_exp2f(mref - mnew);
            mref = mnew; l *= alpha;
            if (hi == 0) wsf[r32] = alpha;
            LDS_WAIT();
#pragma unroll
            for (int r = 0; r < 16; ++r) { const float f = wsf[crow(r, hi)];
#pragma unroll
                for (int d0 = 0; d0 < 4; ++d0) o[d0][r] *= f; }
        }
        float sacc = 0.f;
#pragma unroll
        for (int r = 0; r < 16; ++r) { p0[r] = __builtin_amdgcn_exp2f(p0[r] - mref); p1[r] = __builtin_amdgcn_exp2f(p1[r] - mref); sacc += p0[r] + p1[r]; }
        l += sacc;
        bf16x8 pa[4];
        { u32x4 w;
          w.x = pk2(p0[0], p0[1]); w.y = pk2(p0[2], p0[3]); w.z = pk2(p0[4], p0[5]); w.w = pk2(p0[6], p0[7]); pa[0] = __builtin_bit_cast(bf16x8, w);
          w.x = pk2(p0[8], p0[9]); w.y = pk2(p0[10], p0[11]); w.z = pk2(p0[12], p0[13]); w.w = pk2(p0[14], p0[15]); pa[1] = __builtin_bit_cast(bf16x8, w);
          w.x = pk2(p1[0], p1[1]); w.y = pk2(p1[2], p1[3]); w.z = pk2(p1[4], p1[5]); w.w = pk2(p1[6], p1[7]); pa[2] = __builtin_bit_cast(bf16x8, w);
          w.x = pk2(p1[8], p1[9]); w.y = pk2(p1[10], p1[11]); w.z = pk2(p1[12], p1[13]); w.w = pk2(p1[14], p1[15]); pa[3] = __builtin_bit_cast(bf16x8, w); }
        LAS const unsigned char* vp = lds + VBUF + buf * 16384 + ((lane >> 4) & 1) * 32 + (lane & 3) * 8 + (4 * hi + ((lane & 15) >> 2)) * 64;
#pragma unroll
        for (int d0 = 0; d0 < 4; ++d0)
#pragma unroll
            for (int ks = 0; ks < 4; ++ks) {
                const s16x4 lo = vtr(vp + d0 * 4096 + ks * 1024), hh = vtr(vp + d0 * 4096 + ks * 1024 + 512);
                const bf16x8 vf = {lo[0], lo[1], lo[2], lo[3], hh[0], hh[1], hh[2], hh[3]};
                o[d0] = MFMA32(pa[ks], vf, o[d0]);
            }
        LDS_WAIT();
        __builtin_amdgcn_s_barrier(); asm volatile("" ::: "memory");
    }
#undef DMA_TILE
    { auto rr = __builtin_amdgcn_permlane32_swap(__float_as_uint(l), __float_as_uint(l), false, false); l = __uint_as_float(rr[0]) + __uint_as_float(rr[1]); }
    if (hi == 0) wsf[r32] = 1.0f / l;
    LDS_WAIT();
    float rli[16];
#pragma unroll
    for (int r = 0; r < 16; ++r) rli[r] = wsf[crow(r, hi)];
    LAS float* X = (LAS float*)(lds + XOFF);
    if (comp == 1) {
#pragma unroll
        for (int d0 = 0; d0 < 4; ++d0)
#pragma unroll
            for (int r = 0; r < 16; ++r) X[((wq * 4 + d0) * 16 + r) * 64 + lane] = lam * o[d0][r] * rli[r];
    }
    LDS_WAIT();
    __builtin_amdgcn_s_barrier(); asm volatile("" ::: "memory");
    if (comp == 0) {
        float ssq[16];
#pragma unroll
        for (int r = 0; r < 16; ++r) ssq[r] = 0.f;
#pragma unroll
        for (int d0 = 0; d0 < 4; ++d0)
#pragma unroll
            for (int r = 0; r < 16; ++r) { const float v = o[d0][r] * rli[r] - X[((wq * 4 + d0) * 16 + r) * 64 + lane]; o[d0][r] = v; ssq[r] += v * v; }
#pragma unroll
        for (int r = 0; r < 16; ++r) {
            float s = ssq[r];
            s += __shfl_xor(s, 1); s += __shfl_xor(s, 2); s += __shfl_xor(s, 4); s += __shfl_xor(s, 8); s += __shfl_xor(s, 16);
            ssq[r] = 0.8f / sqrtf(s * (1.0f / 128.0f) + 1e-5f);
        }
        bf16* Ow = CAT + (rowbase + q0 + wq * 32) * 1024 + 512 + h * 128 + r32;
#pragma unroll
        for (int d0 = 0; d0 < 4; ++d0) { const float gsub = subln[d0 * 32 + r32];
#pragma unroll
            for (int r = 0; r < 16; ++r) { const float y = o[d0][r] * ssq[r] * gsub; Ow[(size_t)crow(r, hi) * 1024 + d0 * 32] = (bf16)(pk2(y, 0.f) & 0xffffu); } }
    }
    LDS_WAIT();
    __builtin_amdgcn_s_barrier(); asm volatile("" ::: "memory");
}
}

__device__ __forceinline__ void conv_phase(LAS unsigned char* lds, const bf16* Gt, bf16* Y, const float* dw_w, const float* dw_b, const float* ln_g, const float* ln_b, int vcu, int G) {
    const int tid = opaque_tid(), lane = tid & 63; const int wid = tid >> 6;
    const int c0 = 2 * tid;
    LAS float* red = (LAS float*)(lds + 62 * 2048);
    LAS float* mr = (LAS float*)(lds + 62 * 2048 + 2048);
    const f32x2 bia = *(const f32x2*)(dw_b + c0), gam = *(const f32x2*)(ln_g + c0), bet = *(const f32x2*)(ln_b + c0);
    for (int tile = vcu; tile < 1024; tile += G) {
        const int b = tile >> 8, t0 = (tile & 255) * 32;
        const float* dww = dw_w; asm volatile("" : "+s"(dww));
#pragma unroll 4
        for (int p = tid; p < 62 * 128; p += NWAVES * 64) {
            const int rr = p >> 7, pc = p & 127; const int t = t0 - 30 + rr; u32x4 v = {0u, 0u, 0u, 0u};
            if (t >= 0) v = *(const u32x4*)(Gt + ((size_t)b * SEQ + t) * 1024 + pc * 8);
            *(LAS u32x4*)(lds + rr * 2048 + pc * 16) = v;
        }
        __syncthreads();
        f32x2 av[32];
#pragma unroll
        for (int tt = 0; tt < 32; ++tt) av[tt] = bia;
#pragma unroll
        for (int half = 0; half < 2; ++half) {
            const int j0 = half * 16, nj = half ? 15 : 16;
            f32x2 wv[16];
#pragma unroll
            for (int j = 0; j < 16; ++j) { if (j < nj) wv[j] = *(const f32x2*)(dww + (j0 + j) * 1024 + c0); else wv[j] = (f32x2){0.f, 0.f}; }
#pragma unroll
            for (int th = 0; th < 2; ++th) {
#pragma unroll
                for (int q = 0; q < 31; ++q) {
                    const int rr = 16 * th + j0 + q;
                    const unsigned v = *(LAS const unsigned*)(lds + rr * 2048 + tid * 4); const f32x2 x = {bflo(v), bfhi(v)};
#pragma unroll
                    for (int i = 0; i < 16; ++i) { const int j = q - i; if (j >= 0 && j < nj) av[16 * th + i] += wv[j] * x; }
                }
                asm volatile("" ::: "memory");
            }
        }
        float a0[32], a1[32];
#pragma unroll
        for (int tt = 0; tt < 32; ++tt) { a0[tt] = av[tt][0]; a1[tt] = av[tt][1]; }
        float st[32];
        { const bool bit = (lane & 32) != 0;
#pragma unroll
          for (int i = 0; i < 32; ++i) { const float s1 = a0[i] + a1[i], s2 = a0[i] * a0[i] + a1[i] * a1[i]; const float keep = bit ? s2 : s1, send = bit ? s1 : s2; st[i] = keep + __shfl_xor(send, 32); } }
#define TR_STEP(N) { const bool bit = (lane & N) != 0; _Pragma("unroll") for (int i = 0; i < N; ++i) { const float keep = bit ? st[i + N] : st[i], send = bit ? st[i] : st[i + N]; st[i] = keep + __shfl_xor(send, N); } }
        TR_STEP(16) TR_STEP(8) TR_STEP(4) TR_STEP(2) TR_STEP(1)
#undef TR_STEP
        red[wid * 64 + lane] = st[0];
        __syncthreads();
        if (tid < 32) {
            float s1 = 0.f, s2 = 0.f;
#pragma unroll
            for (int w = 0; w < 8; ++w) { s1 += red[w * 64 + tid]; s2 += red[w * 64 + 32 + tid]; }
            const float mean = s1 * (1.0f / 1024.0f); const float var = fmaxf(s2 * (1.0f / 1024.0f) - mean * mean, 0.f);
            mr[2 * tid] = mean; mr[2 * tid + 1] = 1.0f / sqrtf(var + 1e-5f);
        }
        __syncthreads();
#pragma unroll
        for (int tt = 0; tt < 32; ++tt) {
            const float mean = mr[2 * tt], rstd = mr[2 * tt + 1];
            float y0 = (a0[tt] - mean) * rstd * gam[0] + bet[0], y1 = (a1[tt] - mean) * rstd * gam[1] + bet[1];
            y0 = y0 * __builtin_amdgcn_rcpf(1.0f + __builtin_amdgcn_exp2f(-1.4426950408889634f * y0));
            y1 = y1 * __builtin_amdgcn_rcpf(1.0f + __builtin_amdgcn_exp2f(-1.4426950408889634f * y1));
            *(LAS unsigned*)(lds + tt * 2048 + tid * 4) = pk2(y0, y1);
        }
        __syncthreads();
        {
            bf16* yb = Y + ((size_t)b * SEQ + t0) * 1024;
#pragma unroll 2
            for (int p = tid; p < 32 * 128; p += NWAVES * 64) { const int rr = p >> 7, pc = p & 127; *(u32x4*)(yb + (size_t)rr * 1024 + pc * 8) = *(LAS const u32x4*)(lds + rr * 2048 + pc * 16); }
        }
        __syncthreads();
    }
    __syncthreads();
}


__device__ __forceinline__ void final_phase(float* H, const float* ssp, const float* gfin, int vcu, int G, int wave, int lane) {
    const int gw = vcu * NWAVES + wave, NGW = G * NWAVES;
    f32x4 gv[4];
#pragma unroll
    for (int j = 0; j < 4; ++j) gv[j] = ((const f32x4*)gfin)[lane + 64 * j];
    for (int m = gw; m < M; m += NGW) {
        const float inv = pg8::row_inv_rms(ssp, m);
        f32x4* xr = (f32x4*)(H + (size_t)m * DM) + lane;
#pragma unroll
        for (int j = 0; j < 4; ++j) { f32x4 v = xr[64 * j]; v = v * inv * gv[j]; xr[64 * j] = v; }
    }
}

#define GAS __attribute__((address_space(1)))
#define XB_TMO      128
#define XB_XCNT(j)  (256  + 64 * (j))
#define XB_XSUB(j)  (1280 + 64 * (j))
#define XB_XGEN(j)  (2304 + 64 * (j))
#define XB_TOP      3328
#define XB_TOPGEN   3392
#define XCD_BAR_WORDS 3456
#define XB_SPIN_CAP (1u << 18)

__device__ __forceinline__ unsigned xb_ld(unsigned* p)              { return __hip_atomic_load(p, __ATOMIC_RELAXED, __HIP_MEMORY_SCOPE_AGENT); }
__device__ __forceinline__ unsigned xb_add(unsigned* p, unsigned v) { return __hip_atomic_fetch_add(p, v, __ATOMIC_RELAXED, __HIP_MEMORY_SCOPE_AGENT); }
__device__ __forceinline__ unsigned xb_xcc_id() { return (unsigned)__builtin_amdgcn_s_getreg((3 << 11) | 20) & 0xFu; }
#define XB_SPIN(cond, bar) do { unsigned _sp = 0; while (cond) { __builtin_amdgcn_s_sleep(1); \
    if ((++_sp & 255u) == 0u) { if (xb_ld(&(bar)[XB_TMO])) break; if (_sp > XB_SPIN_CAP) { atomicAdd(&(bar)[XB_TMO], 1u); break; } } } } while (0)

struct XcdBarrier {
    unsigned* bar; unsigned x;
    volatile LAS unsigned* st;
};

__device__ __forceinline__ XcdBarrier xcd_barrier_post(unsigned* bar, volatile LAS unsigned* st) {
    XcdBarrier b; b.bar = bar; b.x = xb_xcc_id(); b.st = st;
    if (threadIdx.x == 0) (void)xb_add(&bar[XB_XCNT(b.x)], 1u);
    return b;
}
__device__ __forceinline__ void xcd_barrier_complete(unsigned* bar, unsigned x, unsigned& nloc, unsigned& nx) {
    const unsigned G = gridDim.x * gridDim.y * gridDim.z;
    unsigned sum, cnt, mine, sp = 0u;
    for (;;) {
        sum = 0u; cnt = 0u; mine = 0u;
#pragma unroll
        for (unsigned j = 0; j < 16; ++j) { const unsigned c = xb_ld(&bar[XB_XCNT(j)]); sum += c; cnt += (c > 0u) ? 1u : 0u; mine = (j == x) ? c : mine; }
        if (sum == G) break;
        __builtin_amdgcn_s_sleep(1);
        if ((++sp & 255u) == 0u) { if (xb_ld(&bar[XB_TMO])) break; if (sp > XB_SPIN_CAP) { atomicAdd(&bar[XB_TMO], 1u); break; } }
    }
    nloc = mine > 0u ? mine : 1u; nx = cnt > 0u ? cnt : 1u;
}

__device__ __forceinline__ void xcd_barrier(const XcdBarrier& b) {
    asm volatile("s_waitcnt vmcnt(0)" ::: "memory");
    __syncthreads();
    if (threadIdx.x == 0) {
        unsigned* bar = b.bar;
        __builtin_amdgcn_s_waitcnt(0);
        unsigned nloc = b.st[0], nx = b.st[1];
        if (nloc == 0u) { xcd_barrier_complete(bar, b.x, nloc, nx); b.st[0] = nloc; b.st[1] = nx; }
        const unsigned old = xb_add(&bar[XB_XSUB(b.x)], 1u);
        const unsigned gen = old / nloc;
        if (old + 1u == (gen + 1u) * nloc) {
            __builtin_amdgcn_fence(__ATOMIC_RELEASE, "agent");
            asm volatile("s_waitcnt vmcnt(0)" ::: "memory");
            const unsigned og = xb_add(&bar[XB_TOP], 1u);
            const unsigned tg = og / nx;
            if (og + 1u == (tg + 1u) * nx) xb_add(&bar[XB_TOPGEN], 1u);
            else XB_SPIN(xb_ld(&bar[XB_TOPGEN]) == tg, bar);
            __builtin_amdgcn_fence(__ATOMIC_ACQUIRE, "agent");
            xb_add(&bar[XB_XGEN(b.x)], 1u);
            asm volatile("s_waitcnt vmcnt(0)" ::: "memory");
        } else {
            XB_SPIN(xb_ld(&bar[XB_XGEN(b.x)]) == gen, bar);
            __builtin_amdgcn_fence(__ATOMIC_ACQUIRE, "agent");
            asm volatile("s_waitcnt vmcnt(0)" ::: "memory");
        }
    }
    __syncthreads();
}

#ifndef PHASE_MASK
#define PHASE_MASK 0xfff
#endif
#define PH(k) ((PHASE_MASK >> (k)) & 1)
__global__ void __launch_bounds__(NWAVES * 64, 2) fwd_megakernel(Args args) {
    extern __shared__ __attribute__((aligned(16))) unsigned char lds_raw[];
    LAS unsigned char* lds = (LAS unsigned char*)lds_raw;
    cg::grid_group grid = cg::this_grid();
    const int tid = threadIdx.x, lane = tid & 63; const int wave = __builtin_amdgcn_readfirstlane(tid >> 6);
    const int G = gridDim.x; const int bx = blockIdx.x; const int vcu = (G % 8 == 0) ? (bx % 8) * (G / 8) + bx / 8 : bx;
    unsigned char* ws = args.ws;
#define WSP(T, off) ((T*)(ws + (off)))
    float* H = args.out;
    unsigned* barw = (unsigned*)(ws + WS_CTL);
    volatile LAS unsigned* bst = (volatile LAS unsigned*)(lds + MISC_OFF);
    if (threadIdx.x < 2) bst[threadIdx.x] = 0u;
    if (blockIdx.x == 0) for (int i = threadIdx.x; i < XCD_BAR_WORDS; i += NWAVES * 64) __hip_atomic_store(barw + i, 0u, __ATOMIC_RELAXED, __HIP_MEMORY_SCOPE_AGENT);
    if (PH(0)) { const int t_ = opaque_tid(); prologue(args, lds, vcu, G, __builtin_amdgcn_readfirstlane(t_ >> 6), t_ & 63); }
    grid.sync();
    const XcdBarrier xbar = xcd_barrier_post(barw, bst);
    if (PH(1)) { pg8::Gemm g{WSP(bf16, WS_AB), WSP(bf16, WS_WIN), M, INW, DM}; pg8::StaticOrder S; S.init(M, INW, G, bx); pg8::EpiIn E{WSP(bf16, WS_Z), WSP(float, WS_ROPE)};
      pg8::gemm_phase<pg8::EpiIn, pg8::StaticOrder, true, true>(lds, g, S, E); }
    xcd_barrier(xbar);
    if (PH(2)) {
        bf16* Z = WSP(bf16, WS_Z); bf16* CAT = WSP(bf16, WS_CAT);
        pool_phase(Z, CAT, vcu, G, opaque_tid());
        float sa = args.in[9][lane] * args.in[10][lane], sb = args.in[11][lane] * args.in[12][lane];
        sa = wave_sum(sa); sb = wave_sum(sb);
        const float lam = __builtin_amdgcn_exp2f(sa * 1.4426950408889634f) - __builtin_amdgcn_exp2f(sb * 1.4426950408889634f) + 0.2f;
        const bf16* Qp = Z + (size_t)M * 512; const bf16* Kp = Z + (size_t)2 * M * 512; const bf16* Vp = Z + (size_t)3 * M * 512;
        for (int u = vcu; u < 16 * 16; u += G) {
            const int bh = u >> 4, s = u & 15;
#pragma unroll 1
            for (int i = 0; i < 4; ++i) { const int qb = (i == 0) ? s : (i == 1) ? 31 - s : (i == 2) ? 32 + s : 63 - s;
                att::attn_unit(bh >> 2, bh & 3, qb, Qp, Kp, Vp, CAT, args.in[13], lam, lds); }
        }
    }
    xcd_barrier(xbar);
    if (PH(3)) { pg8::Gemm g{WSP(bf16, WS_CAT), WSP(bf16, WS_WCAT), M, DM, DM}; pg8::StaticOrder S; S.init(M, DM, G, bx); pg8::EpiRes E{args.in[0], H, WSP(bf16, WS_AB), nullptr, WSP(float, WS_SSP)};
      pg8::gemm_phase<pg8::EpiRes, pg8::StaticOrder, true, true>(lds, g, S, E); }
    xcd_barrier(xbar);
    if (PH(4)) { pg8::Gemm g{WSP(bf16, WS_AB), WSP(bf16, WS_WUP), M, DFF, DM}; pg8::StaticOrder S; S.init(M, DFF, G, bx); pg8::EpiUp E{WSP(bf16, WS_HID), WSP(float, WS_SSP)};
      pg8::gemm_phase<pg8::EpiUp, pg8::StaticOrder, true, true>(lds, g, S, E); }
    xcd_barrier(xbar);
    if (PH(5)) { pg8::Gemm g{WSP(bf16, WS_HID), WSP(bf16, WS_WDN), M, DM, DFF}; pg8::StaticOrder S; S.init(M, DM, G, bx); pg8::EpiRes E{H, H, WSP(bf16, WS_AB), nullptr, WSP(float, WS_SSP)};
      pg8::gemm_phase<pg8::EpiRes, pg8::StaticOrder, true, true>(lds, g, S, E); }
    xcd_barrier(xbar);
    if (PH(6)) { pg8::Gemm g{WSP(bf16, WS_AB), WSP(bf16, WS_PW1), M, INW, DM}; pg8::StaticOrder S; S.init(M, INW, G, bx); pg8::EpiGlu E{WSP(bf16, WS_G), WSP(float, WS_SSP), args.in[16]};
      pg8::gemm_phase<pg8::EpiGlu, pg8::StaticOrder, true, true>(lds, g, S, E); }
    xcd_barrier(xbar);
    if (PH(7)) conv_phase(lds, WSP(bf16, WS_G), WSP(bf16, WS_Y), args.in[17], args.in[18], args.in[19], args.in[20], vcu, G);
    xcd_barrier(xbar);
    if (PH(8)) { pg8::Gemm g{WSP(bf16, WS_Y), WSP(bf16, WS_PW2), M, DM, DM}; pg8::StaticOrder S; S.init(M, DM, G, bx); pg8::EpiRes E{H, H, WSP(bf16, WS_AB), args.in[22], WSP(float, WS_SSP)};
      pg8::gemm_phase<pg8::EpiRes, pg8::StaticOrder, true, true>(lds, g, S, E); }
    xcd_barrier(xbar);
    if (PH(9)) { pg8::Gemm g{WSP(bf16, WS_AB), WSP(bf16, WS_WUP) + (size_t)DFF * DM, M, DFF, DM}; pg8::StaticOrder S; S.init(M, DFF, G, bx); pg8::EpiUp E{WSP(bf16, WS_HID), WSP(float, WS_SSP)};
      pg8::gemm_phase<pg8::EpiUp, pg8::StaticOrder, true, true>(lds, g, S, E); }
    xcd_barrier(xbar);
    if (PH(10)) { pg8::Gemm g{WSP(bf16, WS_HID), WSP(bf16, WS_WDN) + (size_t)DM * DFF, M, DM, DFF}; pg8::StaticOrder S; S.init(M, DM, G, bx); pg8::EpiRes E{H, H, WSP(bf16, WS_AB), nullptr, WSP(float, WS_SSP)};
      pg8::gemm_phase<pg8::EpiRes, pg8::StaticOrder, true, true>(lds, g, S, E); }
    xcd_barrier(xbar);
    if (PH(11)) { const int t_ = opaque_tid(); final_phase(H, WSP(float, WS_SSP), args.in[5], vcu, G, __builtin_amdgcn_readfirstlane(t_ >> 6), t_ & 63); }
}

extern "C" void kernel_launch(void* const* d_in, const int* in_sizes, int n_in, void* d_out, int out_size, void* d_ws, size_t ws_size, hipStream_t stream) {
    static int grid = 0;
    if (grid == 0) {
        if (n_in != 23 || in_sizes[0] != M * DM || out_size != M * DM || ws_size < WS_END) { fprintf(stderr, "kernel_launch: unexpected shapes (n_in %d, in0 %d, out %d, ws %zu)\n", n_in, n_in > 0 ? in_sizes[0] : -1, out_size, ws_size); grid = -1; return; }
        int dev = 0, cus = 0, per_cu = 0;
        if (hipGetDevice(&dev) != hipSuccess || hipDeviceGetAttribute(&cus, hipDeviceAttributeMultiprocessorCount, dev) != hipSuccess) { grid = -1; return; }
        if (hipFuncSetAttribute((const void*)fwd_megakernel, hipFuncAttributeMaxDynamicSharedMemorySize, LDS_BYTES) != hipSuccess) { fprintf(stderr, "kernel_launch: hipFuncSetAttribute failed\n"); grid = -1; return; }
        if (hipOccupancyMaxActiveBlocksPerMultiprocessor(&per_cu, (const void*)fwd_megakernel, NWAVES * 64, LDS_BYTES) != hipSuccess || per_cu < 1) { fprintf(stderr, "kernel_launch: occupancy query says %d\n", per_cu); per_cu = 1; }
        (void)hipGetLastError();
        grid = cus * 1;
        fprintf(stderr, "kernel_launch: grid %d (cus %d, occupancy %d)\n", grid, cus, per_cu);
    }
    if (grid < 0) return;
    Args a{};
    for (int i = 0; i < 23; ++i) a.in[i] = (const float*)d_in[i];
    a.out = (float*)d_out; a.ws = (unsigned char*)d_ws;
    for (int i = 0; i < 8; ++i) a.invf[i] = (float)std::pow(500000.0, -(double)i / 8.0);
    void* kargs[] = {&a};
    hipError_t e = hipLaunchCooperativeKernel((const void*)fwd_megakernel, dim3(grid), dim3(NWAVES * 64), kargs, LDS_BYTES, stream);
    if (e != hipSuccess) fprintf(stderr, "kernel_launch: cooperative launch failed: %s (grid %d)\n", hipGetErrorString(e), grid);
}
```

```cpp
#include <hip/hip_runtime.h>
#include <hip/hip_cooperative_groups.h>
#include <cstdio>
#include <cstdint>
#include <cmath>
namespace cg = cooperative_groups;

__device__ __forceinline__ int opaque_tid() { int t = threadIdx.x; asm volatile("" : "+v"(t)); return t; }

namespace pg8 {
#define PG8_LAS __attribute__((address_space(3)))
typedef unsigned short bf16_t;
typedef short bf16x8 __attribute__((ext_vector_type(8)));
typedef float f32x4 __attribute__((ext_vector_type(4)));
typedef unsigned u32x4 __attribute__((ext_vector_type(4)));
constexpr int BM = 256, BK = 64, HALF = 128, HTB = HALF * BK * 2  , STAGE_BYTES = 8 * HTB, NXCD = 8, WGM = 8;

__host__ __device__ __forceinline__ int lds_byte(int r, int c) { const int st = (r >> 4) * 2 + (c >> 5), rr = r & 15, cc = c & 31, ob = rr * 64 + cc * 2; return st * 1024 + (ob ^ (((ob >> 9) & 1) << 5)); }
__host__ __device__ __forceinline__ void stage_rc(int b, int& R, int& C) { const int st = b / 1024, sb = b % 1024, swz = sb ^ (((sb >> 9) & 1) << 5); R = (st >> 1) * 16 + swz / 64; C = (st & 1) * 32 + (swz % 64) / 2; }
__host__ __device__ __forceinline__ int perm32(int rho) { const int n = rho >> 4, i = rho & 15; return 8 * (i >> 2) + 4 * n + (i & 3); }

struct Unit { int pm, pn; };
struct Gemm { const bf16_t* A; const bf16_t* Bt; int M, N, K; };

struct StaticOrder {
    int nM, nN, nwg, G, c;
    __host__ __device__ void init(int M, int N, int G_, int c_) { nM = M / BM; nN = N / BM; nwg = nM * nN; G = G_; c = c_; }
    __host__ __device__ bool next(int i, Unit& u) const {
        const long L = (long)i * G + c; if (L >= nwg) return false;
        int wgid = (int)L; { const int q = nwg / NXCD, r = nwg % NXCD, xcd = wgid % NXCD, off = wgid / NXCD; wgid = (xcd < r ? xcd * (q + 1) : r * (q + 1) + (xcd - r) * q) + off; }
        const int nig = WGM * nN, gid = wgid / nig, fm = gid * WGM, gsz = (nM - fm) < WGM ? (nM - fm) : WGM;
        u.pm = fm + ((wgid % nig) % gsz); u.pn = (wgid % nig) / gsz; return true;
    }
    __device__ __forceinline__ void a_ready(const Unit&) const {}
    __device__ __forceinline__ void done(const Unit&) const {}
};

typedef float f32x2v __attribute__((ext_vector_type(2))); typedef __bf16 bf16x2v __attribute__((ext_vector_type(2)));
__device__ __forceinline__ unsigned cvt_pk_bf16(float lo, float hi) { f32x2v v = {lo, hi}; bf16x2v b = __builtin_convertvector(v, bf16x2v); return __builtin_bit_cast(unsigned, b); }
__device__ __forceinline__ u32x4 pack8(const f32x4& v0, const f32x4& v1) { u32x4 w; w.x = cvt_pk_bf16(v0[0], v0[1]); w.y = cvt_pk_bf16(v0[2], v0[3]); w.z = cvt_pk_bf16(v1[0], v1[1]); w.w = cvt_pk_bf16(v1[2], v1[3]); return w; }

constexpr int MROWS = 32768;
constexpr float C2 = 0.125f * 1.4426950408889634f;
constexpr float RMS_EPS = 1e-6f;

__device__ __forceinline__ float row_inv_rms(const float* ssp, int row) {
    const f32x4* p = (const f32x4*)(ssp + (size_t)row * 16);
    const f32x4 a = p[0], b = p[1], c = p[2], d = p[3];
    const float s = ((a[0] + a[1]) + (a[2] + a[3])) + ((b[0] + b[1]) + (b[2] + b[3])) + ((c[0] + c[1]) + (c[2] + c[3])) + ((d[0] + d[1]) + (d[2] + d[3]));
    return 1.0f / sqrtf(s * (1.0f / 1024.0f) + RMS_EPS);
}

struct EpiIn {
    static constexpr bool PERM = true, AFTER_DRAIN = false;
    bf16_t* Z; const float* rope;
    __device__ __forceinline__ void operator()(const f32x4 (&acc)[2][2][4][2], const Unit& u, int wr, int wc, int fr, int fq) const {
        const int sec = u.pn >> 1;
        bf16_t* base = Z + (size_t)sec * MROWS * 512;
        const int cs0 = (u.pn & 1) * 256 + wc * 32 + 8 * fq;
        const int row0 = u.pm * BM + wr * 64 + fr;
        const bool ropew = (sec == 1 || sec == 2) && ((wc & 1) == 0);
        const float sc = (sec == 1) ? C2 : 1.0f;
#pragma unroll
        for (int ai = 0; ai < 2; ++ai)
#pragma unroll
            for (int m = 0; m < 4; ++m) {
                const int row = row0 + ai * HALF + m * 16; const int pos = row & 8191;
                f32x4 c0 = {1.f, 1.f, 1.f, 1.f}, c1 = c0, s0 = {0.f, 0.f, 0.f, 0.f}, s1 = s0;
                if (ropew) { const f32x4* cp = (const f32x4*)(rope + (size_t)pos * 8); const f32x4* sp = (const f32x4*)(rope + 65536 + (size_t)pos * 8); c0 = cp[0]; c1 = cp[1]; s0 = sp[0]; s1 = sp[1]; }
#pragma unroll
                for (int bj = 0; bj < 2; ++bj) {
                    f32x4 v0 = acc[ai][bj][m][0], v1 = acc[ai][bj][m][1];
                    if (ropew) {
                        f32x4 p0, p1;
#pragma unroll
                        for (int e = 0; e < 4; ++e) { p0[e] = __shfl_xor(v0[e], 16); p1[e] = __shfl_xor(v1[e], 16); }
                        if (fq == 0) { v0 = v0 * c0 - p0 * s0; v1 = v1 * c1 - p1 * s1; }
                        else if (fq == 1) { v0 = v0 * c0 + p0 * s0; v1 = v1 * c1 + p1 * s1; }
                    }
                    v0 = v0 * sc; v1 = v1 * sc;
                    *(u32x4*)(base + (size_t)row * 512 + cs0 + bj * HALF) = pack8(v0, v1);
                }
            }
    }
};

struct EpiRes {
    static constexpr bool PERM = true, AFTER_DRAIN = false;
    const float* R; float* H; bf16_t* HB; const float* bias; float* ssp;
    __device__ __forceinline__ void operator()(const f32x4 (&acc)[2][2][4][2], const Unit& u, int wr, int wc, int fr, int fq) const {
        const int row0 = u.pm * BM + wr * 64 + fr, col0 = u.pn * BM + wc * 32 + 8 * fq;
        f32x4 bv[2][2];
#pragma unroll
        for (int bj = 0; bj < 2; ++bj)
#pragma unroll
            for (int n = 0; n < 2; ++n) bv[bj][n] = bias ? *(const f32x4*)(bias + col0 + bj * HALF + 4 * n) : (f32x4){0.f, 0.f, 0.f, 0.f};
#pragma unroll
        for (int ai = 0; ai < 2; ++ai)
#pragma unroll
            for (int m = 0; m < 4; ++m) {
                const int row = row0 + ai * HALF + m * 16; float ss = 0.f;
#pragma unroll
                for (int bj = 0; bj < 2; ++bj) {
                    const size_t off = (size_t)row * 1024 + col0 + bj * HALF;
                    const f32x4 r0 = *(const f32x4*)(R + off), r1 = *(const f32x4*)(R + off + 4);
                    const f32x4 v0 = acc[ai][bj][m][0] + bv[bj][0] + r0, v1 = acc[ai][bj][m][1] + bv[bj][1] + r1;
                    *(f32x4*)(H + off) = v0; *(f32x4*)(H + off + 4) = v1;
                    *(u32x4*)(HB + off) = pack8(v0, v1);
                    ss += (v0[0] * v0[0] + v0[1] * v0[1]) + (v0[2] * v0[2] + v0[3] * v0[3]) + (v1[0] * v1[0] + v1[1] * v1[1]) + (v1[2] * v1[2] + v1[3] * v1[3]);
                }
                ss += __shfl_xor(ss, 16); ss += __shfl_xor(ss, 32);
                if (fq == 0) ssp[(size_t)row * 16 + u.pn * 4 + wc] = ss;
                asm volatile("" ::: "memory");
            }
    }
};

struct EpiUp {
    static constexpr bool PERM = true, AFTER_DRAIN = false;
    bf16_t* O; const float* ssp;
    __device__ __forceinline__ void operator()(const f32x4 (&acc)[2][2][4][2], const Unit& u, int wr, int wc, int fr, int fq) const {
        const int row0 = u.pm * BM + wr * 64 + fr, col0 = u.pn * BM + wc * 32 + 8 * fq;
#pragma unroll
        for (int ai = 0; ai < 2; ++ai)
#pragma unroll
            for (int m = 0; m < 4; ++m) {
                const int row = row0 + ai * HALF + m * 16; const float s = row_inv_rms(ssp, row);
#pragma unroll
                for (int bj = 0; bj < 2; ++bj) {
                    f32x4 v0 = acc[ai][bj][m][0] * s, v1 = acc[ai][bj][m][1] * s;
#pragma unroll
                    for (int e = 0; e < 4; ++e) { const float a = fmaxf(v0[e], 0.f), b = fmaxf(v1[e], 0.f); v0[e] = a * a; v1[e] = b * b; }
                    *(u32x4*)(O + (size_t)row * 4096 + col0 + bj * HALF) = pack8(v0, v1);
                }
                asm volatile("" ::: "memory");
            }
    }
};

struct EpiGlu {
    static constexpr bool PERM = true, AFTER_DRAIN = false;
    bf16_t* O; const float* ssp; const float* bias;
    __device__ __forceinline__ void operator()(const f32x4 (&acc)[2][2][4][2], const Unit& u, int wr, int wc, int fr, int fq) const {
        const int row0 = u.pm * BM + wr * 64 + fr, col0 = u.pn * HALF + wc * 32 + 8 * fq;
        const f32x4 bv0 = *(const f32x4*)(bias + col0), bv1 = *(const f32x4*)(bias + col0 + 4), bg0 = *(const f32x4*)(bias + 1024 + col0), bg1 = *(const f32x4*)(bias + 1024 + col0 + 4);
#pragma unroll
        for (int ai = 0; ai < 2; ++ai)
#pragma unroll
            for (int m = 0; m < 4; ++m) {
                const int row = row0 + ai * HALF + m * 16; const float s = row_inv_rms(ssp, row);
                f32x4 a0 = acc[ai][0][m][0] * s + bv0, a1 = acc[ai][0][m][1] * s + bv1;
                const f32x4 g0 = acc[ai][1][m][0] * s + bg0, g1 = acc[ai][1][m][1] * s + bg1;
#pragma unroll
                for (int e = 0; e < 4; ++e) {
                    a0[e] = a0[e] * __builtin_amdgcn_rcpf(1.0f + __builtin_amdgcn_exp2f(-1.4426950408889634f * g0[e]));
                    a1[e] = a1[e] * __builtin_amdgcn_rcpf(1.0f + __builtin_amdgcn_exp2f(-1.4426950408889634f * g1[e]));
                }
                *(u32x4*)(O + (size_t)row * 1024 + col0) = pack8(a0, a1);
                asm volatile("" ::: "memory");
            }
    }
};

template <class Epi, class Sched, bool ALIGN_EPI = false, bool SP2 = false>
__device__ __forceinline__ void gemm_phase(PG8_LAS unsigned char* lds, const Gemm g, const Sched& S, const Epi& E) {
    const int tid = opaque_tid(), wid = __builtin_amdgcn_readfirstlane(tid >> 6), lane = tid & 63, wr = wid >> 2, wc = wid & 3, fr = lane & 15, fq = lane >> 4;
    const int K = g.K, nt = K / BK;
    unsigned voffA[2], voffB[2];
#pragma unroll
    for (int i = 0; i < 2; ++i) { int R, C; stage_rc(tid * 16 + i * 8192, R, C); const int Rb = Epi::PERM ? ((R & ~31) + perm32(R & 31)) : R;
        voffA[i] = (unsigned)(R * K + C) * 2u; voffB[i] = (unsigned)(Rb * K + C) * 2u; }
    const size_t kstep = (size_t)(BK * 2);
    const size_t hstep = (size_t)HALF * K * 2;
    const size_t tstep = 2 * hstep;
    const unsigned ldsw = (unsigned)wid * 1024u;
    const int aoff = lds_byte(wr * 64 + fr, fq * 8), boff = lds_byte(wc * 32 + fr, fq * 8);
#define PG8_SA(b, h) (((b) * 2 + (h)) * HTB)
#define PG8_SB(b, h) ((4 + (b) * 2 + (h)) * HTB)
#define PG8_STAGE(bufoff, gbase, voff) do { _Pragma("unroll") for (int _i = 0; _i < 2; ++_i) \
        __builtin_amdgcn_global_load_lds((const unsigned*)((const char*)(gbase) + (voff)[_i]), (PG8_LAS unsigned*)(lds + (bufoff) + ldsw + _i * 8192), 16, 0, 0); } while (0)
#define PG8_LDA(dst, b, h) do { _Pragma("unroll") for (int m = 0; m < 4; ++m) _Pragma("unroll") for (int k = 0; k < 2; ++k) dst[m][k] = *(const PG8_LAS bf16x8*)(lds + PG8_SA(b, h) + aoff + m * 2048 + k * 1024); } while (0)
#define PG8_LDB(dst, b, h) do { _Pragma("unroll") for (int n = 0; n < 2; ++n) _Pragma("unroll") for (int k = 0; k < 2; ++k) dst[n][k] = *(const PG8_LAS bf16x8*)(lds + PG8_SB(b, h) + boff + n * 2048 + k * 1024); } while (0)
#define PG8_MMA(ai, bj, At, Bt) do { __builtin_amdgcn_s_setprio(1); _Pragma("unroll") for (int m = 0; m < 4; ++m) _Pragma("unroll") for (int n = 0; n < 2; ++n) _Pragma("unroll") for (int k = 0; k < 2; ++k) \
        acc[ai][bj][m][n] = __builtin_amdgcn_mfma_f32_16x16x32_bf16(Bt[n][k], At[m][k], acc[ai][bj][m][n], 0, 0, 0); __builtin_amdgcn_s_setprio(0); } while (0)
#define PG8_WAIT_V(n) asm volatile("s_waitcnt vmcnt(" #n ")" ::: "memory")
#define PG8_WAIT_L(n) asm volatile("s_waitcnt lgkmcnt(" #n ")" ::: "memory")
#define PG8_BAR __builtin_amdgcn_s_barrier()
#define PG8_SCHED __builtin_amdgcn_sched_barrier(0)
    Unit cur, nxt; int ui = 0;
    if (!S.next(0, cur)) return;
    f32x4 acc[2][2][4][2];
#pragma unroll
    for (int a = 0; a < 2; ++a)
#pragma unroll
        for (int b = 0; b < 2; ++b)
#pragma unroll
            for (int m = 0; m < 4; ++m)
#pragma unroll
                for (int n = 0; n < 2; ++n) acc[a][b][m][n] = (f32x4){0.f, 0.f, 0.f, 0.f};
    bf16x8 At[4][2], B0[2][2], B1[2][2];
    const char* cA = (const char*)g.A + (size_t)cur.pm * tstep; const char* cB = (const char*)g.Bt + (size_t)cur.pn * tstep;
    S.a_ready(cur);
    if constexpr (SP2) {
        PG8_STAGE(PG8_SB(0, 0), cB, voffB); PG8_STAGE(PG8_SB(0, 1), cB + hstep, voffB); PG8_STAGE(PG8_SA(0, 0), cA, voffA); PG8_STAGE(PG8_SA(0, 1), cA + hstep, voffA);
        if (wr == 1) PG8_BAR;
        PG8_WAIT_V(2); PG8_BAR;
        PG8_STAGE(PG8_SB(1, 0), cB + kstep, voffB); PG8_STAGE(PG8_SA(1, 0), cA + kstep, voffA); PG8_STAGE(PG8_SB(1, 1), cB + hstep + kstep, voffB);
        PG8_WAIT_V(6); PG8_BAR;
    } else {
        PG8_STAGE(PG8_SB(0, 0), cB, voffB); PG8_STAGE(PG8_SA(0, 0), cA, voffA); PG8_STAGE(PG8_SB(0, 1), cB + hstep, voffB); PG8_STAGE(PG8_SA(0, 1), cA + hstep, voffA);
        if (wr == 1) PG8_BAR;
        PG8_WAIT_V(4); PG8_BAR;
        PG8_STAGE(PG8_SB(1, 0), cB + kstep, voffB); PG8_STAGE(PG8_SA(1, 0), cA + kstep, voffA); PG8_STAGE(PG8_SB(1, 1), cB + hstep + kstep, voffB);
        PG8_WAIT_V(6); PG8_BAR;
    }
    for (;;) {
        const bool has_next = S.next(ui + 1, nxt);
        const char* nA = has_next ? (const char*)g.A + (size_t)nxt.pm * tstep : cA; const char* nB = has_next ? (const char*)g.Bt + (size_t)nxt.pn * tstep : cB;
        for (int t = 0; t < nt; t += 2) {
            const bool last = (t == nt - 2);
            const char* a1 = cA + (size_t)(t + 1) * kstep;
            const char* a2 = last ? nA : cA + (size_t)(t + 2) * kstep; const char* b2 = last ? nB : cB + (size_t)(t + 2) * kstep;
            const char* a3 = a2 + kstep; const char* b3 = b2 + kstep;
            if (last && has_next) S.a_ready(nxt);
            if constexpr (SP2) {
            PG8_LDB(B0, 0, 0); PG8_LDB(B1, 0, 1); PG8_SCHED; PG8_LDA(At, 0, 0); PG8_STAGE(PG8_SA(1, 1), a1 + hstep, voffA);
            PG8_WAIT_V(8); PG8_WAIT_L(0); PG8_BAR; PG8_MMA(0, 0, At, B0); PG8_MMA(0, 1, At, B1); PG8_BAR; PG8_SCHED;
            PG8_LDA(At, 0, 1); PG8_STAGE(PG8_SB(0, 0), b2, voffB); PG8_STAGE(PG8_SB(0, 1), b2 + hstep, voffB); PG8_STAGE(PG8_SA(0, 0), a2, voffA);
            PG8_WAIT_V(8); PG8_WAIT_L(0); PG8_BAR; PG8_MMA(1, 0, At, B0); PG8_MMA(1, 1, At, B1); PG8_BAR; PG8_SCHED;
            PG8_LDB(B0, 1, 0); PG8_LDB(B1, 1, 1); PG8_SCHED; PG8_LDA(At, 1, 0); PG8_STAGE(PG8_SA(0, 1), a2 + hstep, voffA);
            PG8_WAIT_V(8); PG8_WAIT_L(0); PG8_BAR; PG8_MMA(0, 0, At, B0); PG8_MMA(0, 1, At, B1); PG8_BAR; PG8_SCHED;
            PG8_LDA(At, 1, 1); PG8_STAGE(PG8_SB(1, 0), b3, voffB); PG8_STAGE(PG8_SB(1, 1), b3 + hstep, voffB); PG8_STAGE(PG8_SA(1, 0), a3, voffA);
            PG8_WAIT_V(8); PG8_WAIT_L(0); PG8_BAR; PG8_MMA(1, 0, At, B0); PG8_MMA(1, 1, At, B1); PG8_BAR; PG8_SCHED;
            } else {
            PG8_LDB(B0, 0, 0); PG8_SCHED; PG8_LDA(At, 0, 0); PG8_STAGE(PG8_SA(1, 1), a1 + hstep, voffA);
            PG8_WAIT_L(8); PG8_BAR; PG8_WAIT_L(0); PG8_MMA(0, 0, At, B0); PG8_BAR; PG8_SCHED;
            PG8_LDB(B1, 0, 1); PG8_STAGE(PG8_SB(0, 0), b2, voffB);
            PG8_BAR; PG8_WAIT_L(0); PG8_MMA(0, 1, At, B1); PG8_BAR;
            PG8_LDA(At, 0, 1); PG8_STAGE(PG8_SA(0, 0), a2, voffA);
            PG8_BAR; PG8_WAIT_L(0); PG8_MMA(1, 0, At, B0); PG8_BAR; PG8_SCHED;
            PG8_STAGE(PG8_SB(0, 1), b2 + hstep, voffB);
            PG8_WAIT_V(6); PG8_BAR; PG8_MMA(1, 1, At, B1); PG8_BAR;
            PG8_LDB(B0, 1, 0); PG8_SCHED; PG8_LDA(At, 1, 0); PG8_STAGE(PG8_SA(0, 1), a2 + hstep, voffA);
            PG8_WAIT_L(8); PG8_BAR; PG8_WAIT_L(0); PG8_MMA(0, 0, At, B0); PG8_BAR; PG8_SCHED;
            PG8_LDB(B1, 1, 1); PG8_STAGE(PG8_SB(1, 0), b3, voffB);
            PG8_BAR; PG8_WAIT_L(0); PG8_MMA(0, 1, At, B1); PG8_BAR;
            PG8_LDA(At, 1, 1); PG8_STAGE(PG8_SA(1, 0), a3, voffA);
            PG8_BAR; PG8_WAIT_L(0); PG8_MMA(1, 0, At, B0); PG8_BAR; PG8_SCHED;
            PG8_STAGE(PG8_SB(1, 1), b3 + hstep, voffB);
            PG8_WAIT_V(6); PG8_BAR; PG8_MMA(1, 1, At, B1); PG8_BAR;
            }
        }
        if constexpr (ALIGN_EPI) { if (wr == 0) PG8_BAR; }
        if constexpr (!Epi::AFTER_DRAIN) { E(acc, cur, wr, wc, fr, fq); S.done(cur); }
        if (!has_next) break;
#pragma unroll
        for (int a = 0; a < 2; ++a)
#pragma unroll
            for (int b = 0; b < 2; ++b)
#pragma unroll
                for (int m = 0; m < 4; ++m)
#pragma unroll
                    for (int n = 0; n < 2; ++n) acc[a][b][m][n] = (f32x4){0.f, 0.f, 0.f, 0.f};
        cur = nxt; cA = nA; cB = nB; ++ui;
        if constexpr (ALIGN_EPI) { if (wr == 1) PG8_BAR; }
    }
    PG8_WAIT_V(0);
    if constexpr (!ALIGN_EPI) { if (wr == 0) PG8_BAR; }
    PG8_BAR;
    if constexpr (Epi::AFTER_DRAIN) { E.fused(acc, cur, wr, wc, fr, fq, lds, wid, lane); S.done(cur); }
#undef PG8_SA
#undef PG8_SB
#undef PG8_STAGE
#undef PG8_LDA
#undef PG8_LDB
#undef PG8_MMA
#undef PG8_WAIT_V
#undef PG8_WAIT_L
#undef PG8_BAR
#undef PG8_SCHED
}
}

#define LAS __attribute__((address_space(3)))
typedef unsigned short bf16;
typedef unsigned u32x4 __attribute__((ext_vector_type(4)));
typedef unsigned u32x2 __attribute__((ext_vector_type(2)));
typedef float f32x4 __attribute__((ext_vector_type(4)));
typedef float f32x2 __attribute__((ext_vector_type(2)));
typedef float f32x16 __attribute__((ext_vector_type(16)));
typedef short bf16x8 __attribute__((ext_vector_type(8)));
typedef short s16x4 __attribute__((ext_vector_type(4)));
#define LDS_WAIT() asm volatile("s_waitcnt lgkmcnt(0)" ::: "memory")

constexpr int NWAVES = 8;
constexpr int BATCH = 4, SEQ = 8192, DM = 1024, M = BATCH * SEQ, DFF = 4096, INW = 2048;
constexpr int LDS_BYTES = 147456, MISC_OFF = 147200;
constexpr size_t MiB = 1u << 20;
constexpr size_t WS_CTL = 0;
constexpr size_t WS_WIN = 1 * MiB;
constexpr size_t WS_WCAT = 5 * MiB;
constexpr size_t WS_WUP = 7 * MiB;
constexpr size_t WS_WDN = 23 * MiB;
constexpr size_t WS_PW1 = 39 * MiB;
constexpr size_t WS_PW2 = 43 * MiB;
constexpr size_t WS_ROPE = 45 * MiB;
constexpr size_t WS_SSP = 46 * MiB;
constexpr size_t WS_AB = 48 * MiB;
constexpr size_t WS_BIG = 112 * MiB;
constexpr size_t WS_Z = WS_BIG, WS_CAT = WS_BIG + 128 * MiB, WS_HID = WS_BIG, WS_G = WS_BIG, WS_Y = WS_BIG + 64 * MiB;
constexpr size_t WS_END = WS_BIG + 256 * MiB;

__device__ __forceinline__ unsigned pk2(float lo, float hi) { return pg8::cvt_pk_bf16(lo, hi); }
__device__ __forceinline__ float bflo(unsigned v) { return __uint_as_float(v << 16); }
__device__ __forceinline__ float bfhi(unsigned v) { return __uint_as_float(v & 0xffff0000u); }
__device__ __forceinline__ float wave_sum(float v) {
#pragma unroll
    for (int o = 1; o < 64; o <<= 1) v += __shfl_xor(v, o);
    return v;
}

__device__ __forceinline__ void tr_item(const float* W, int ldw, int k0, int n0, const float* gain, bf16* WT, int ldt, int drow0, LAS float* scr, int lane) {
#pragma unroll 8
    for (int i = 0; i < 32; ++i) { const int kk = 2 * i + (lane >> 5); const float g = gain ? gain[k0 + kk] : 1.0f; scr[kk * 33 + (lane & 31)] = W[(size_t)(k0 + kk) * ldw + n0 + (lane & 31)] * g; }
    LDS_WAIT();
    const int c = lane & 7;
#pragma unroll
    for (int j = 0; j < 4; ++j) { const int n = (lane >> 3) + 8 * j; const LAS float* s = scr + (8 * c) * 33 + n;
        u32x4 o; o.x = pk2(s[0 * 33], s[1 * 33]); o.y = pk2(s[2 * 33], s[3 * 33]); o.z = pk2(s[4 * 33], s[5 * 33]); o.w = pk2(s[6 * 33], s[7 * 33]);
        *(u32x4*)(WT + (size_t)(drow0 + n) * ldt + k0 + 8 * c) = o; }
    LDS_WAIT();
}
__device__ __forceinline__ void tr_matrix_item(const float* W, int K, int N, int kbase, const float* gain, bf16* WT, int ldt, int item, bool glu, LAS float* scr, int lane) {
    const int nblk = N / 32, kb = item / nblk, nb = item % nblk; const int k0 = kbase + 64 * kb, n0 = 32 * nb;
    int drow0 = n0;
    if (glu) { const int half = n0 >= 1024 ? 1 : 0, j = n0 - half * 1024; drow0 = 256 * (j >> 7) + 128 * half + (j & 127); }
    tr_item(W, N, k0, n0, gain, WT, ldt, drow0, scr, lane);
}

struct Args {
    const float* in[23]; float* out; unsigned char* ws; float invf[8];
};

__device__ __forceinline__ void prologue(const Args& a, LAS unsigned char* lds, int vcu, int G, int wave, int lane) {
    unsigned char* ws = a.ws;
    LAS float* scr = (LAS float*)(lds + wave * 16384);
    const int gw = vcu * NWAVES + wave, NGW = G * NWAVES;
    const float* x = a.in[0]; const float* mix_norm = a.in[1]; const float* mlp_norm = a.in[2]; const float* w_up = a.in[3]; const float* w_down = a.in[4];
    const float* w_in = a.in[6]; const float* pool_w = a.in[7]; const float* pool_scale = a.in[8]; const float* w_out = a.in[14];
    const float* pw1 = a.in[15]; const float* pw2 = a.in[21];
    bf16* WIN = (bf16*)(ws + WS_WIN); bf16* WCAT = (bf16*)(ws + WS_WCAT); bf16* WUP = (bf16*)(ws + WS_WUP); bf16* WDN = (bf16*)(ws + WS_WDN);
    bf16* PW1 = (bf16*)(ws + WS_PW1); bf16* PW2 = (bf16*)(ws + WS_PW2);
    constexpr int I_IN = 16 * 64, I_OUT = 8 * 32, I_UP = 16 * 128, I_DN = 64 * 32, I_PW1 = 16 * 64, I_PW2 = 16 * 32;
    constexpr int NITEMS = I_IN + I_OUT + 2 * I_UP + 2 * I_DN + I_PW1 + I_PW2;
    for (int it = gw; it < NITEMS; it += NGW) {
        int r = it;
        if (r < I_IN) { tr_matrix_item(w_in, 1024, 2048, 0, nullptr, WIN, 1024, r, false, scr, lane); continue; } r -= I_IN;
        if (r < I_OUT) { tr_matrix_item(w_out, 512, 1024, 512, nullptr, WCAT, 1024, r, false, scr, lane); continue; } r -= I_OUT;
        if (r < I_UP) { tr_matrix_item(w_up, 1024, 4096, 0, mlp_norm, WUP, 1024, r, false, scr, lane); continue; } r -= I_UP;
        if (r < I_UP) { tr_matrix_item(w_up + (size_t)1024 * 4096, 1024, 4096, 0, mlp_norm + 1024, WUP + (size_t)4096 * 1024, 1024, r, false, scr, lane); continue; } r -= I_UP;
        if (r < I_DN) { tr_matrix_item(w_down, 4096, 1024, 0, nullptr, WDN, 4096, r, false, scr, lane); continue; } r -= I_DN;
        if (r < I_DN) { tr_matrix_item(w_down + (size_t)4096 * 1024, 4096, 1024, 0, nullptr, WDN + (size_t)1024 * 4096, 4096, r, false, scr, lane); continue; } r -= I_DN;
        if (r < I_PW1) { tr_matrix_item(pw1, 1024, 2048, 0, mix_norm + 1024, PW1, 1024, r, true, scr, lane); continue; } r -= I_PW1;
        tr_matrix_item(pw2, 1024, 1024, 0, nullptr, PW2, 1024, r, false, scr, lane);
    }
    for (int it = gw; it < 16 * 64; it += NGW) {
        const int nb = it & 15, kb = it >> 4; const int n = nb * 64 + lane, k0 = kb * 8, g = k0 >> 7;
        float acc8[8];
#pragma unroll
        for (int i = 0; i < 8; ++i) acc8[i] = 0.f;
        for (int d = 0; d < 128; ++d) {
            const float wv = w_out[(size_t)(g * 128 + d) * 1024 + n] * pool_scale[g * 128 + d];
#pragma unroll
            for (int i = 0; i < 8; ++i) acc8[i] += pool_w[(size_t)(k0 + i) * 128 + d] * wv;
        }
        u32x4 o; o.x = pk2(acc8[0], acc8[1]); o.y = pk2(acc8[2], acc8[3]); o.z = pk2(acc8[4], acc8[5]); o.w = pk2(acc8[6], acc8[7]);
        *(u32x4*)(WCAT + (size_t)n * 1024 + k0) = o;
    }
    {
        float* rope = (float*)(ws + WS_ROPE);
        const int gt = (vcu * NWAVES + wave) * 64 + lane, NGT = NGW * 64;
        for (int idx = gt; idx < 8192 * 8; idx += NGT) {
            const int pos = idx >> 3, i = idx & 7;
            const float angf = (float)pos * a.invf[i];
            const double ang = (double)angf;
            const double n = __builtin_rint(ang * 0.15915494309189535);
            const double y = ang - n * 6.283185307179586476925;
            const double y2 = y * y;
            double sp = 1.0, cp = 1.0;
#pragma unroll
            for (int k = 13; k >= 1; --k) { sp = 1.0 - sp * y2 / (double)((2 * k) * (2 * k + 1)); cp = 1.0 - cp * y2 / (double)((2 * k - 1) * (2 * k)); }
            rope[idx] = (float)cp; rope[65536 + idx] = (float)(y * sp);
        }
    }
    {
        bf16* XN = (bf16*)(ws + WS_AB);
        f32x4 gv[4];
#pragma unroll
        for (int j = 0; j < 4; ++j) gv[j] = ((const f32x4*)mix_norm)[lane + 64 * j];
        for (int m = gw; m < M; m += NGW) {
            const f32x4* xr = (const f32x4*)(x + (size_t)m * DM) + lane;
            f32x4 v[4]; float s = 0.f;
#pragma unroll
            for (int j = 0; j < 4; ++j) { v[j] = xr[64 * j]; s += (v[j][0] * v[j][0] + v[j][1] * v[j][1]) + (v[j][2] * v[j][2] + v[j][3] * v[j][3]); }
            const float inv = 1.0f / sqrtf(wave_sum(s) * (1.0f / DM) + 1e-6f);
            u32x2* o8 = (u32x2*)(XN + (size_t)m * DM) + lane;
#pragma unroll
            for (int j = 0; j < 4; ++j) { u32x2 o; o.x = pk2(v[j][0] * inv * gv[j][0], v[j][1] * inv * gv[j][1]); o.y = pk2(v[j][2] * inv * gv[j][2], v[j][3] * inv * gv[j][3]); o8[64 * j] = o; }
        }
    }
}

__device__ __forceinline__ void pool_phase(const bf16* U, bf16* CAT, int vcu, int G, int tid) {
    const int gt = vcu * (NWAVES * 64) + tid, NGT = G * NWAVES * 64;
    for (int it = gt; it < M * 64; it += NGT) {
        const int row = it >> 6, c8 = it & 63; const int t = row & (SEQ - 1); const int g = c8 >> 4; const int w = 2 << g;
        const int cnt = (t + 1 < w) ? (t + 1) : w;
        float s[8];
#pragma unroll
        for (int e = 0; e < 8; ++e) s[e] = 0.f;
        float tok[8];
        for (int j = 0; j < cnt; ++j) {
            const u32x4 v = *(const u32x4*)(U + (size_t)(row - j) * 512 + c8 * 8);
            const float f[8] = {bflo(v.x), bfhi(v.x), bflo(v.y), bfhi(v.y), bflo(v.z), bfhi(v.z), bflo(v.w), bfhi(v.w)};
#pragma unroll
            for (int e = 0; e < 8; ++e) { s[e] += f[e]; if (j == 0) tok[e] = f[e]; }
        }
        const float ic = 1.0f / (float)cnt;
        u32x4 o; o.x = pk2(s[0] * ic - tok[0], s[1] * ic - tok[1]); o.y = pk2(s[2] * ic - tok[2], s[3] * ic - tok[3]);
        o.z = pk2(s[4] * ic - tok[4], s[5] * ic - tok[5]); o.w = pk2(s[6] * ic - tok[6], s[7] * ic - tok[7]);
        *(u32x4*)(CAT + (size_t)row * 1024 + c8 * 8) = o;
    }
}

namespace att {
constexpr int KBUF = 0, VBUF = 49152, XOFF = 0, WSF = 98304, SLOT = 16384;
__device__ __forceinline__ int crow(int r, int hi) { return (r & 3) + 8 * (r >> 2) + 4 * hi; }
__device__ __forceinline__ void glds16(const void* gsrc, unsigned lds_dst) { unsigned keep;
    asm volatile("s_mov_b32 %0, m0\n\ts_mov_b32 m0, %2\n\ts_nop 0\n\tglobal_load_lds_dwordx4 %1, off\n\ts_mov_b32 m0, %0" : "=&s"(keep) : "v"(gsrc), "s"(lds_dst) : "memory"); }
typedef short v4i16_t __attribute__((ext_vector_type(4)));
__device__ __forceinline__ s16x4 vtr(LAS const unsigned char* p) { return __builtin_bit_cast(s16x4, __builtin_amdgcn_ds_read_tr16_b64_v4i16((LAS v4i16_t*)p)); }
#define MX3(a, b, c) __builtin_fmaxf(__builtin_fmaxf((a), (b)), (c))
#define MFMA32(a, b, c) __builtin_amdgcn_mfma_f32_32x32x16_bf16(a, b, c, 0, 0, 0)
#define SBAR() __builtin_amdgcn_sched_barrier(0)
#define PIN(x) asm volatile("" : "+v"(x))
constexpr float THR = 8.0f;

__device__ __forceinline__ bf16x8 vfrag(LAS const unsigned char* vp, int i) {
    const int off = (i & 3) * 4096 + (i >> 2) * 1024;
    const s16x4 lo = vtr(vp + off), hh = vtr(vp + off + 512);
    return (bf16x8){lo[0], lo[1], lo[2], lo[3], hh[0], hh[1], hh[2], hh[3]};
}
__device__ __forceinline__ bf16x8 kfrag(LAS const unsigned char* kp, int j) {
    return *(LAS const bf16x8*)(kp + (j >> 1) * 2048 + (j & 1) * 512);
}
#define SEL32(A, B, e) ((e) < 16 ? A[(e) & 15] : B[(e) & 15])

template <bool DO_PV, bool DO_QK, bool BAND>
__device__ __forceinline__ void step(f32x16& S0, f32x16& S1, f32x16& T0, f32x16& T1, f32x16 (&o)[4], u32x4 (&pw)[4], const bf16x8 (&qr)[4],
                                     float& mref, float& l, float& alpha, bool& resc, LAS const unsigned char* kp, LAS const unsigned char* vp, int jb, int qrel, int hi) {
    bf16x8 vf[16]; bf16x8 kf[8];
    if (DO_PV) { vf[0] = vfrag(vp, 0); vf[1] = vfrag(vp, 1); }
    if (BAND) {
        const int kb = 64 * jb + 4 * hi;
#pragma unroll
        for (int r = 0; r < 16; ++r) { const int kv = kb + (r & 3) + 8 * (r >> 2); if (kv > qrel) S0[r] = -INFINITY; if (kv + 32 > qrel) S1[r] = -INFINITY; }
    }
    SBAR();
    float ma = 0.f, mb = 0.f, rm = 0.f;
#pragma unroll
    for (int i = 0; i < 16; ++i) {
        if (DO_PV) { if (i + 2 < 16) vf[i + 2] = vfrag(vp, i + 2); o[i & 3] = MFMA32(__builtin_bit_cast(bf16x8, pw[i >> 2]), vf[i], o[i & 3]); }
        if (i == 0) { ma = MX3(S0[0], S0[1], S1[0]); mb = MX3(S0[2], S0[3], S1[1]); ma = MX3(ma, S1[2], S1[3]);
                      ma = MX3(ma, S0[4], S0[5]); mb = MX3(mb, S0[6], S0[7]); PIN(ma); PIN(mb); }
        else if (i == 1) { ma = MX3(ma, S1[4], S1[5]); mb = MX3(mb, S1[6], S1[7]); ma = MX3(ma, S0[8], S0[9]); mb = MX3(mb, S0[10], S0[11]); ma = MX3(ma, S1[8], S1[9]); PIN(ma); PIN(mb); }
        else if (i == 2) { mb = MX3(mb, S1[10], S1[11]); ma = MX3(ma, S0[12], S0[13]); mb = MX3(mb, S0[14], S0[15]); ma = MX3(ma, S1[12], S1[13]); mb = MX3(mb, S1[14], S1[15]);
                           rm = __builtin_fmaxf(ma, mb); PIN(rm); }
        else if (i == 3) {
            auto rr = __builtin_amdgcn_permlane32_swap(__float_as_uint(rm), __float_as_uint(rm), false, false);
            rm = __builtin_fmaxf(__uint_as_float(rr[0]), __uint_as_float(rr[1]));
            const bool grow = rm > mref + THR; const float mnew = grow ? rm : mref;
            alpha = __builtin_amdgcn_exp2f(mref - mnew); l *= alpha; mref = mnew; resc = __any(grow);
            PIN(mref); PIN(l);
        }
        if (i >= 3) {
            const int e0 = ((i - 3) * 32) / 13, e1 = ((i - 2) * 32) / 13;
#pragma unroll
            for (int e = e0; e < e1; ++e) { if (e < 16) S0[e] = __builtin_amdgcn_exp2f(S0[e] - mref); else S1[e - 16] = __builtin_amdgcn_exp2f(S1[e - 16] - mref); }
            PIN(S0); PIN(S1);
        }
        SBAR();
    }
    if (DO_QK) { kf[0] = kfrag(kp, 0); kf[1] = kfrag(kp, 1); T0 = f32x16{}; T1 = f32x16{}; }
    float sacc = 0.f;
#pragma unroll
    for (int j = 0; j < 8; ++j) {
        if (DO_QK) { if (j + 2 < 8) kf[j + 2] = kfrag(kp, j + 2); if (j & 1) T1 = MFMA32(kf[j], qr[j >> 1], T1); else T0 = MFMA32(kf[j], qr[j >> 1], T0); }
        const int e = 4 * j;
        const float x0 = SEL32(S0, S1, e), x1 = SEL32(S0, S1, e + 1), x2 = SEL32(S0, S1, e + 2), x3 = SEL32(S0, S1, e + 3);
        sacc += x0; sacc += x1; sacc += x2; sacc += x3; PIN(sacc);
        const unsigned w0 = pk2(x0, x1), w1 = pk2(x2, x3);
        if (j & 1) { pw[j >> 1].z = w0; pw[j >> 1].w = w1; } else { pw[j >> 1].x = w0; pw[j >> 1].y = w1; }
        PIN(pw[j >> 1]);
        SBAR();
    }
    l += sacc;
}

__device__ __forceinline__ void attn_unit(int b, int h, int qb, const bf16* Q, const bf16* K, const bf16* V, bf16* CAT, const float* subln, float lam, LAS unsigned char* lds) {
    const int tid = opaque_tid(), lane = tid & 63, r32 = lane & 31, hi = lane >> 5; const int wid = __builtin_amdgcn_readfirstlane(tid >> 6);
    const int comp = wid >> 2, wq = wid & 3;
    const size_t rowbase = (size_t)b * SEQ; const int q0 = qb * 128; const int NT = (q0 + 128) / 64;
    const unsigned lds0 = (unsigned)(size_t)lds;
    LAS float* wsf = (LAS float*)(lds + WSF) + wid * 64;
    const bf16* Qw = Q + (rowbase + q0 + wq * 32 + r32) * 512 + h * 128 + comp * 64;
    bf16x8 qr[4];
#pragma unroll
    for (int d0 = 0; d0 < 4; ++d0) qr[d0] = *(const bf16x8*)(Qw + d0 * 16 + hi * 8);
    const bf16* ksrc[2]; const bf16* vsrc[2]; unsigned kdst[2], vdst[2];
#pragma unroll
    for (int i = 0; i < 2; ++i) { const int p = 2 * wid + i; const int kc = p >> 3, ch = p & 7, db = p >> 2, rg = p & 3;
        ksrc[i] = K + (rowbase + lane) * 512 + h * 128 + kc * 64 + ch * 8; kdst[i] = lds0 + KBUF + kc * 8192 + ch * 1024;
        vsrc[i] = V + (rowbase + 16 * rg + (lane >> 2)) * 512 + h * 128 + db * 32 + (lane & 3) * 8; vdst[i] = lds0 + VBUF + db * 4096 + rg * 1024; }
#define DMA_K(t) do { const unsigned so_ = (unsigned)(((t) % 3) * SLOT); _Pragma("unroll") for (int i_ = 0; i_ < 2; ++i_) glds16(ksrc[i_] + (size_t)(t) * 64 * 512, (unsigned)__builtin_amdgcn_readfirstlane(kdst[i_] + so_)); } while (0)
#define DMA_V(t) do { const unsigned so_ = (unsigned)(((t) % 3) * SLOT); _Pragma("unroll") for (int i_ = 0; i_ < 2; ++i_) glds16(vsrc[i_] + (size_t)(t) * 64 * 512, (unsigned)__builtin_amdgcn_readfirstlane(vdst[i_] + so_)); } while (0)
    f32x16 o[4];
#pragma unroll
    for (int d0 = 0; d0 < 4; ++d0) o[d0] = f32x16{};
    float mref = -INFINITY, l = 0.f, alpha = 1.f; bool resc = false;
    const int qrel = wq * 32 + r32;
    u32x4 pw[4];
#pragma unroll
    for (int k = 0; k < 4; ++k) pw[k] = (u32x4){0u, 0u, 0u, 0u};
    LAS const unsigned char* kbase = lds + KBUF + comp * 8192 + hi * 1024 + r32 * 16;
    LAS const unsigned char* vbase = lds + VBUF + ((lane >> 4) & 1) * 32 + (lane & 3) * 8 + (4 * hi + ((lane & 15) >> 2)) * 64;
    asm volatile("s_waitcnt vmcnt(0)" ::: "memory");
    DMA_K(0); DMA_V(0); DMA_K(1); if (2 < NT) DMA_K(2);
    if (2 < NT) asm volatile("s_waitcnt vmcnt(6)" ::: "memory"); else asm volatile("s_waitcnt vmcnt(4)" ::: "memory");
    __builtin_amdgcn_s_barrier(); asm volatile("" ::: "memory");
    f32x16 SA = f32x16{}, SB = f32x16{}, TA, TB;
#pragma unroll
    for (int j = 0; j < 8; ++j) { const bf16x8 kf = kfrag(kbase, j); if (j & 1) SB = MFMA32(kf, qr[j >> 1], SB); else SA = MFMA32(kf, qr[j >> 1], SA); }
    if (2 < NT) asm volatile("s_waitcnt vmcnt(2) lgkmcnt(0)" ::: "memory"); else asm volatile("s_waitcnt vmcnt(0) lgkmcnt(0)" ::: "memory");
    __builtin_amdgcn_s_barrier(); asm volatile("" ::: "memory");
#define ITER(DP, DQ, BD, S0_, S1_, T0_, T1_, t_, jb_) do { const int tt_ = (t_); \
        int nfl_ = 0; if (tt_ + 3 < NT) { DMA_K(tt_ + 3); nfl_ += 2; } if (tt_ + 1 < NT) { DMA_V(tt_ + 1); nfl_ += 2; } \
        int ko_ = ((tt_ + 1) % 3) * SLOT, vo_ = ((tt_ + 2) % 3) * SLOT; asm volatile("" : "+s"(ko_), "+s"(vo_));     \
        step<DP, DQ, BD>(S0_, S1_, T0_, T1_, o, pw, qr, mref, l, alpha, resc, kbase + ko_, vbase + vo_, (jb_), qrel, hi); \
        if (nfl_ == 4) asm volatile("s_waitcnt vmcnt(4) lgkmcnt(0)" ::: "memory"); else if (nfl_ == 2) asm volatile("s_waitcnt vmcnt(2) lgkmcnt(0)" ::: "memory"); else asm volatile("s_waitcnt vmcnt(0) lgkmcnt(0)" ::: "memory"); \
        __builtin_amdgcn_s_barrier(); asm volatile("" ::: "memory"); \
        if (resc) { if (hi == 0) wsf[r32] = alpha; LDS_WAIT(); \
            _Pragma("unroll") for (int r = 0; r < 16; ++r) { const float f_ = wsf[crow(r, hi)]; _Pragma("unroll") for (int d0 = 0; d0 < 4; ++d0) o[d0][r] *= f_; } } \
    } while (0)
    if (NT == 2) {
        ITER(false, true, true, SA, SB, TA, TB, 0, 0);
        ITER(true, false, true, TA, TB, SA, SB, 1, 1);
    } else {
        ITER(false, true, false, SA, SB, TA, TB, 0, 0);
        ITER(true, true, false, TA, TB, SA, SB, 1, 0);
        for (int t = 2; t < NT - 2; t += 2) {
            ITER(true, true, false, SA, SB, TA, TB, t, 0);
            ITER(true, true, false, TA, TB, SA, SB, t + 1, 0);
        }
        ITER(true, true, true, SA, SB, TA, TB, NT - 2, 0);
        ITER(true, false, true, TA, TB, SA, SB, NT - 1, 1);
    }
#undef ITER
    {
        int vo_ = ((NT - 1) % 3) * SLOT; asm volatile("" : "+s"(vo_));
        LAS const unsigned char* vp = vbase + vo_;
#pragma unroll
        for (int i = 0; i < 16; ++i) o[i & 3] = MFMA32(__builtin_bit_cast(bf16x8, pw[i >> 2]), vfrag(vp, i), o[i & 3]);
    }
    LDS_WAIT();
    __builtin_amdgcn_s_barrier(); asm volatile("" ::: "memory");
#undef DMA_K
#undef DMA_V
    const int tid2 = opaque_tid(), lane2 = tid2 & 63, r32b = lane2 & 31, hib = lane2 >> 5;
    LAS float* wsf2 = (LAS float*)(lds + WSF) + __builtin_amdgcn_readfirstlane(tid2 >> 6) * 64;
    { auto rr = __builtin_amdgcn_permlane32_swap(__float_as_uint(l), __float_as_uint(l), false, false); l = __uint_as_float(rr[0]) + __uint_as_float(rr[1]); }
    if (hib == 0) wsf2[r32b] = 1.0f / l;
    LDS_WAIT();
    float rli[16];
#pragma unroll
    for (int r = 0; r < 16; ++r) rli[r] = wsf2[crow(r, hib)];
    LAS float* X = (LAS float*)(lds + XOFF);
    if (comp == 1) {
#pragma unroll
        for (int d0 = 0; d0 < 4; ++d0)
#pragma unroll
            for (int r = 0; r < 16; ++r) X[((wq * 4 + d0) * 16 + r) * 64 + lane2] = lam * o[d0][r] * rli[r];
    }
    LDS_WAIT();
    __builtin_amdgcn_s_barrier(); asm volatile("" ::: "memory");
    if (comp == 0) {
        float ssq[16];
#pragma unroll
        for (int r = 0; r < 16; ++r) ssq[r] = 0.f;
#pragma unroll
        for (int d0 = 0; d0 < 4; ++d0)
#pragma unroll
            for (int r = 0; r < 16; ++r) { const float v = o[d0][r] * rli[r] - X[((wq * 4 + d0) * 16 + r) * 64 + lane2]; o[d0][r] = v; ssq[r] += v * v; }
#pragma unroll
        for (int r = 0; r < 16; ++r) {
            float s = ssq[r];
            s += __shfl_xor(s, 1); s += __shfl_xor(s, 2); s += __shfl_xor(s, 4); s += __shfl_xor(s, 8); s += __shfl_xor(s, 16);
            ssq[r] = 0.8f / sqrtf(s * (1.0f / 128.0f) + 1e-5f);
        }
        bf16* Ow = CAT + (rowbase + q0 + wq * 32) * 1024 + 512 + h * 128 + r32b;
#pragma unroll
        for (int d0 = 0; d0 < 4; ++d0) { const float gsub = subln[d0 * 32 + r32b];
#pragma unroll
            for (int r = 0; r < 16; ++r) { const float y = o[d0][r] * ssq[r] * gsub; Ow[(size_t)crow(r, hib) * 1024 + d0 * 32] = (bf16)(pk2(y, 0.f) & 0xffffu); } }
    }
    LDS_WAIT();
    __builtin_amdgcn_s_barrier(); asm volatile("" ::: "memory");
}
}

__device__ __forceinline__ void conv_phase(LAS unsigned char* lds, const bf16* Gt, bf16* Y, const float* dw_w, const float* dw_b, const float* ln_g, const float* ln_b, int vcu, int G) {
    const int tid = opaque_tid(), lane = tid & 63; const int wid = tid >> 6;
    const int c0 = 2 * tid;
    LAS float* red = (LAS float*)(lds + 62 * 2048);
    LAS float* mr = (LAS float*)(lds + 62 * 2048 + 2048);
    const f32x2 bia = *(const f32x2*)(dw_b + c0), gam = *(const f32x2*)(ln_g + c0), bet = *(const f32x2*)(ln_b + c0);
    for (int tile = vcu; tile < 1024; tile += G) {
        const int b = tile >> 8, t0 = (tile & 255) * 32;
        const float* dww = dw_w; asm volatile("" : "+s"(dww));
#pragma unroll 4
        for (int p = tid; p < 62 * 128; p += NWAVES * 64) {
            const int rr = p >> 7, pc = p & 127; const int t = t0 - 30 + rr; u32x4 v = {0u, 0u, 0u, 0u};
            if (t >= 0) v = *(const u32x4*)(Gt + ((size_t)b * SEQ + t) * 1024 + pc * 8);
            *(LAS u32x4*)(lds + rr * 2048 + pc * 16) = v;
        }
        __syncthreads();
        f32x2 av[32];
#pragma unroll
        for (int tt = 0; tt < 32; ++tt) av[tt] = bia;
#pragma unroll
        for (int half = 0; half < 2; ++half) {
            const int j0 = half * 16, nj = half ? 15 : 16;
            f32x2 wv[16];
#pragma unroll
            for (int j = 0; j < 16; ++j) { if (j < nj) wv[j] = *(const f32x2*)(dww + (j0 + j) * 1024 + c0); else wv[j] = (f32x2){0.f, 0.f}; }
#pragma unroll
            for (int th = 0; th < 2; ++th) {
#pragma unroll
                for (int q = 0; q < 31; ++q) {
                    const int rr = 16 * th + j0 + q;
                    const unsigned v = *(LAS const unsigned*)(lds + rr * 2048 + tid * 4); const f32x2 x = {bflo(v), bfhi(v)};
#pragma unroll
                    for (int i = 0; i < 16; ++i) { const int j = q - i; if (j >= 0 && j < nj) av[16 * th + i] += wv[j] * x; }
                }
                asm volatile("" ::: "memory");
            }
        }
        float a0[32], a1[32];
#pragma unroll
        for (int tt = 0; tt < 32; ++tt) { a0[tt] = av[tt][0]; a1[tt] = av[tt][1]; }
        float st[32];
        { const bool bit = (lane & 32) != 0;
#pragma unroll
          for (int i = 0; i < 32; ++i) { const float s1 = a0[i] + a1[i], s2 = a0[i] * a0[i] + a1[i] * a1[i]; const float keep = bit ? s2 : s1, send = bit ? s1 : s2; st[i] = keep + __shfl_xor(send, 32); } }
#define TR_STEP(N) { const bool bit = (lane & N) != 0; _Pragma("unroll") for (int i = 0; i < N; ++i) { const float keep = bit ? st[i + N] : st[i], send = bit ? st[i] : st[i + N]; st[i] = keep + __shfl_xor(send, N); } }
        TR_STEP(16) TR_STEP(8) TR_STEP(4) TR_STEP(2) TR_STEP(1)
#undef TR_STEP
        red[wid * 64 + lane] = st[0];
        __syncthreads();
        if (tid < 32) {
            float s1 = 0.f, s2 = 0.f;
#pragma unroll
            for (int w = 0; w < 8; ++w) { s1 += red[w * 64 + tid]; s2 += red[w * 64 + 32 + tid]; }
            const float mean = s1 * (1.0f / 1024.0f); const float var = fmaxf(s2 * (1.0f / 1024.0f) - mean * mean, 0.f);
            mr[2 * tid] = mean; mr[2 * tid + 1] = 1.0f / sqrtf(var + 1e-5f);
        }
        __syncthreads();
#pragma unroll
        for (int tt = 0; tt < 32; ++tt) {
            const float mean = mr[2 * tt], rstd = mr[2 * tt + 1];
            float y0 = (a0[tt] - mean) * rstd * gam[0] + bet[0], y1 = (a1[tt] - mean) * rstd * gam[1] + bet[1];
            y0 = y0 * __builtin_amdgcn_rcpf(1.0f + __builtin_amdgcn_exp2f(-1.4426950408889634f * y0));
            y1 = y1 * __builtin_amdgcn_rcpf(1.0f + __builtin_amdgcn_exp2f(-1.4426950408889634f * y1));
            *(LAS unsigned*)(lds + tt * 2048 + tid * 4) = pk2(y0, y1);
        }
        __syncthreads();
        {
            bf16* yb = Y + ((size_t)b * SEQ + t0) * 1024;
#pragma unroll 2
            for (int p = tid; p < 32 * 128; p += NWAVES * 64) { const int rr = p >> 7, pc = p & 127; *(u32x4*)(yb + (size_t)rr * 1024 + pc * 8) = *(LAS const u32x4*)(lds + rr * 2048 + pc * 16); }
        }
        __syncthreads();
    }
    __syncthreads();
}


__device__ __forceinline__ void final_phase(float* H, const float* ssp, const float* gfin, int vcu, int G, int wave, int lane) {
    const int gw = vcu * NWAVES + wave, NGW = G * NWAVES;
    f32x4 gv[4];
#pragma unroll
    for (int j = 0; j < 4; ++j) gv[j] = ((const f32x4*)gfin)[lane + 64 * j];
    for (int m = gw; m < M; m += NGW) {
        const float inv = pg8::row_inv_rms(ssp, m);
        f32x4* xr = (f32x4*)(H + (size_t)m * DM) + lane;
#pragma unroll
        for (int j = 0; j < 4; ++j) { f32x4 v = xr[64 * j]; v = v * inv * gv[j]; xr[64 * j] = v; }
    }
}

#define GAS __attribute__((address_space(1)))
#define XB_TMO      128
#define XB_XCNT(j)  (256  + 64 * (j))
#define XB_XSUB(j)  (1280 + 64 * (j))
#define XB_XGEN(j)  (2304 + 64 * (j))
#define XB_TOP      3328
#define XB_TOPGEN   3392
#define XCD_BAR_WORDS 3456
#define XB_SPIN_CAP (1u << 18)

__device__ __forceinline__ unsigned xb_ld(unsigned* p)              { return __hip_atomic_load(p, __ATOMIC_RELAXED, __HIP_MEMORY_SCOPE_AGENT); }
__device__ __forceinline__ unsigned xb_add(unsigned* p, unsigned v) { return __hip_atomic_fetch_add(p, v, __ATOMIC_RELAXED, __HIP_MEMORY_SCOPE_AGENT); }
__device__ __forceinline__ unsigned xb_xcc_id() { return (unsigned)__builtin_amdgcn_s_getreg((3 << 11) | 20) & 0xFu; }
#define XB_SPIN(cond, bar) do { unsigned _sp = 0; while (cond) { __builtin_amdgcn_s_sleep(1); \
    if ((++_sp & 255u) == 0u) { if (xb_ld(&(bar)[XB_TMO])) break; if (_sp > XB_SPIN_CAP) { atomicAdd(&(bar)[XB_TMO], 1u); break; } } } } while (0)

struct XcdBarrier {
    unsigned* bar; unsigned x;
    volatile LAS unsigned* st;
};

__device__ __forceinline__ XcdBarrier xcd_barrier_post(unsigned* bar, volatile LAS unsigned* st) {
    XcdBarrier b; b.bar = bar; b.x = xb_xcc_id(); b.st = st;
    if (threadIdx.x == 0) (void)xb_add(&bar[XB_XCNT(b.x)], 1u);
    return b;
}
__device__ __forceinline__ void xcd_barrier_complete(unsigned* bar, unsigned x, unsigned& nloc, unsigned& nx) {
    const unsigned G = gridDim.x * gridDim.y * gridDim.z;
    unsigned sum, cnt, mine, sp = 0u;
    for (;;) {
        sum = 0u; cnt = 0u; mine = 0u;
#pragma unroll
        for (unsigned j = 0; j < 16; ++j) { const unsigned c = xb_ld(&bar[XB_XCNT(j)]); sum += c; cnt += (c > 0u) ? 1u : 0u; mine = (j == x) ? c : mine; }
        if (sum == G) break;
        __builtin_amdgcn_s_sleep(1);
        if ((++sp & 255u) == 0u) { if (xb_ld(&bar[XB_TMO])) break; if (sp > XB_SPIN_CAP) { atomicAdd(&bar[XB_TMO], 1u); break; } }
    }
    nloc = mine > 0u ? mine : 1u; nx = cnt > 0u ? cnt : 1u;
}

__device__ __forceinline__ void xcd_barrier(const XcdBarrier& b) {
    asm volatile("s_waitcnt vmcnt(0)" ::: "memory");
    __syncthreads();
    if (threadIdx.x == 0) {
        unsigned* bar = b.bar;
        __builtin_amdgcn_s_waitcnt(0);
        unsigned nloc = b.st[0], nx = b.st[1];
        if (nloc == 0u) { xcd_barrier_complete(bar, b.x, nloc, nx); b.st[0] = nloc; b.st[1] = nx; }
        const unsigned old = xb_add(&bar[XB_XSUB(b.x)], 1u);
        const unsigned gen = old / nloc;
        if (old + 1u == (gen + 1u) * nloc) {
            __builtin_amdgcn_fence(__ATOMIC_RELEASE, "agent");
            asm volatile("s_waitcnt vmcnt(0)" ::: "memory");
            const unsigned og = xb_add(&bar[XB_TOP], 1u);
            const unsigned tg = og / nx;
            if (og + 1u == (tg + 1u) * nx) xb_add(&bar[XB_TOPGEN], 1u);
            else XB_SPIN(xb_ld(&bar[XB_TOPGEN]) == tg, bar);
            __builtin_amdgcn_fence(__ATOMIC_ACQUIRE, "agent");
            xb_add(&bar[XB_XGEN(b.x)], 1u);
            asm volatile("s_waitcnt vmcnt(0)" ::: "memory");
        } else {
            XB_SPIN(xb_ld(&bar[XB_XGEN(b.x)]) == gen, bar);
            __builtin_amdgcn_fence(__ATOMIC_ACQUIRE, "agent");
            asm volatile("s_waitcnt vmcnt(0)" ::: "memory");
        }
    }
    __syncthreads();
}

#ifndef PHASE_MASK
#define PHASE_MASK 0xfff
#endif
#define PH(k) ((PHASE_MASK >> (k)) & 1)
#ifndef PROBE_REPEAT
#define PROBE_REPEAT -1
#endif
#define REP(k) for (int rep_ = 0; rep_ < ((k) == PROBE_REPEAT ? 2 : 1); ++rep_)
__global__ void __launch_bounds__(NWAVES * 64, 2) fwd_megakernel(Args args) {
    extern __shared__ __attribute__((aligned(16))) unsigned char lds_raw[];
    LAS unsigned char* lds = (LAS unsigned char*)lds_raw;
    cg::grid_group grid = cg::this_grid();
    const int tid = threadIdx.x, lane = tid & 63; const int wave = __builtin_amdgcn_readfirstlane(tid >> 6);
    const int G = gridDim.x; const int bx = blockIdx.x; const int vcu = (G % 8 == 0) ? (bx % 8) * (G / 8) + bx / 8 : bx;
    unsigned char* ws = args.ws;
#define WSP(T, off) ((T*)(ws + (off)))
    float* H = args.out;
    unsigned* barw = (unsigned*)(ws + WS_CTL);
    volatile LAS unsigned* bst = (volatile LAS unsigned*)(lds + MISC_OFF);
    if (threadIdx.x < 2) bst[threadIdx.x] = 0u;
    if (blockIdx.x == 0) for (int i = threadIdx.x; i < XCD_BAR_WORDS; i += NWAVES * 64) __hip_atomic_store(barw + i, 0u, __ATOMIC_RELAXED, __HIP_MEMORY_SCOPE_AGENT);
    REP(0) if (PH(0)) { const int t_ = opaque_tid(); prologue(args, lds, vcu, G, __builtin_amdgcn_readfirstlane(t_ >> 6), t_ & 63); }
    grid.sync();
    const XcdBarrier xbar = xcd_barrier_post(barw, bst);
    REP(1) if (PH(1)) { pg8::Gemm g{WSP(bf16, WS_AB), WSP(bf16, WS_WIN), M, INW, DM}; pg8::StaticOrder S; S.init(M, INW, G, bx); pg8::EpiIn E{WSP(bf16, WS_Z), WSP(float, WS_ROPE)};
      pg8::gemm_phase<pg8::EpiIn, pg8::StaticOrder, true, true>(lds, g, S, E); }
    xcd_barrier(xbar);
    REP(2) if (PH(2)) {
        bf16* Z = WSP(bf16, WS_Z); bf16* CAT = WSP(bf16, WS_CAT);
        pool_phase(Z, CAT, vcu, G, opaque_tid());
        float sa = args.in[9][lane] * args.in[10][lane], sb = args.in[11][lane] * args.in[12][lane];
        sa = wave_sum(sa); sb = wave_sum(sb);
        const float lam = __builtin_amdgcn_exp2f(sa * 1.4426950408889634f) - __builtin_amdgcn_exp2f(sb * 1.4426950408889634f) + 0.2f;
        const bf16* Qp = Z + (size_t)M * 512; const bf16* Kp = Z + (size_t)2 * M * 512; const bf16* Vp = Z + (size_t)3 * M * 512;
        for (int u = vcu; u < 16 * 16; u += G) {
            const int bh = u >> 4, s = u & 15;
#pragma unroll 1
            for (int i = 0; i < 4; ++i) { const int qb = (i == 0) ? s : (i == 1) ? 31 - s : (i == 2) ? 32 + s : 63 - s;
                att::attn_unit(bh >> 2, bh & 3, qb, Qp, Kp, Vp, CAT, args.in[13], lam, lds); }
        }
    }
    xcd_barrier(xbar);
    REP(3) if (PH(3)) { pg8::Gemm g{WSP(bf16, WS_CAT), WSP(bf16, WS_WCAT), M, DM, DM}; pg8::StaticOrder S; S.init(M, DM, G, bx); pg8::EpiRes E{args.in[0], H, WSP(bf16, WS_AB), nullptr, WSP(float, WS_SSP)};
      pg8::gemm_phase<pg8::EpiRes, pg8::StaticOrder, true, true>(lds, g, S, E); }
    xcd_barrier(xbar);
    REP(4) if (PH(4)) { pg8::Gemm g{WSP(bf16, WS_AB), WSP(bf16, WS_WUP), M, DFF, DM}; pg8::StaticOrder S; S.init(M, DFF, G, bx); pg8::EpiUp E{WSP(bf16, WS_HID), WSP(float, WS_SSP)};
      pg8::gemm_phase<pg8::EpiUp, pg8::StaticOrder, true, true>(lds, g, S, E); }
    xcd_barrier(xbar);
    REP(5) if (PH(5)) { pg8::Gemm g{WSP(bf16, WS_HID), WSP(bf16, WS_WDN), M, DM, DFF}; pg8::StaticOrder S; S.init(M, DM, G, bx); pg8::EpiRes E{H, H, WSP(bf16, WS_AB), nullptr, WSP(float, WS_SSP)};
      pg8::gemm_phase<pg8::EpiRes, pg8::StaticOrder, true, true>(lds, g, S, E); }
    xcd_barrier(xbar);
    REP(6) if (PH(6)) { pg8::Gemm g{WSP(bf16, WS_AB), WSP(bf16, WS_PW1), M, INW, DM}; pg8::StaticOrder S; S.init(M, INW, G, bx); pg8::EpiGlu E{WSP(bf16, WS_G), WSP(float, WS_SSP), args.in[16]};
      pg8::gemm_phase<pg8::EpiGlu, pg8::StaticOrder, true, true>(lds, g, S, E); }
    xcd_barrier(xbar);
    REP(7) if (PH(7)) conv_phase(lds, WSP(bf16, WS_G), WSP(bf16, WS_Y), args.in[17], args.in[18], args.in[19], args.in[20], vcu, G);
    xcd_barrier(xbar);
    REP(8) if (PH(8)) { pg8::Gemm g{WSP(bf16, WS_Y), WSP(bf16, WS_PW2), M, DM, DM}; pg8::StaticOrder S; S.init(M, DM, G, bx); pg8::EpiRes E{H, H, WSP(bf16, WS_AB), args.in[22], WSP(float, WS_SSP)};
      pg8::gemm_phase<pg8::EpiRes, pg8::StaticOrder, true, true>(lds, g, S, E); }
    xcd_barrier(xbar);
    REP(9) if (PH(9)) { pg8::Gemm g{WSP(bf16, WS_AB), WSP(bf16, WS_WUP) + (size_t)DFF * DM, M, DFF, DM}; pg8::StaticOrder S; S.init(M, DFF, G, bx); pg8::EpiUp E{WSP(bf16, WS_HID), WSP(float, WS_SSP)};
      pg8::gemm_phase<pg8::EpiUp, pg8::StaticOrder, true, true>(lds, g, S, E); }
    xcd_barrier(xbar);
    REP(10) if (PH(10)) { pg8::Gemm g{WSP(bf16, WS_HID), WSP(bf16, WS_WDN) + (size_t)DM * DFF, M, DM, DFF}; pg8::StaticOrder S; S.init(M, DM, G, bx); pg8::EpiRes E{H, H, WSP(bf16, WS_AB), nullptr, WSP(float, WS_SSP)};
      pg8::gemm_phase<pg8::EpiRes, pg8::StaticOrder, true, true>(lds, g, S, E); }
    xcd_barrier(xbar);
    if (PH(11)) { const int t_ = opaque_tid(); final_phase(H, WSP(float, WS_SSP), args.in[5], vcu, G, __builtin_amdgcn_readfirstlane(t_ >> 6), t_ & 63); }
}

extern "C" void kernel_launch(void* const* d_in, const int* in_sizes, int n_in, void* d_out, int out_size, void* d_ws, size_t ws_size, hipStream_t stream) {
    static int grid = 0;
    if (grid == 0) {
        if (n_in != 23 || in_sizes[0] != M * DM || out_size != M * DM || ws_size < WS_END) { fprintf(stderr, "kernel_launch: unexpected shapes (n_in %d, in0 %d, out %d, ws %zu)\n", n_in, n_in > 0 ? in_sizes[0] : -1, out_size, ws_size); grid = -1; return; }
        int dev = 0, cus = 0, per_cu = 0;
        if (hipGetDevice(&dev) != hipSuccess || hipDeviceGetAttribute(&cus, hipDeviceAttributeMultiprocessorCount, dev) != hipSuccess) { grid = -1; return; }
        if (hipFuncSetAttribute((const void*)fwd_megakernel, hipFuncAttributeMaxDynamicSharedMemorySize, LDS_BYTES) != hipSuccess) { fprintf(stderr, "kernel_launch: hipFuncSetAttribute failed\n"); grid = -1; return; }
        if (hipOccupancyMaxActiveBlocksPerMultiprocessor(&per_cu, (const void*)fwd_megakernel, NWAVES * 64, LDS_BYTES) != hipSuccess || per_cu < 1) { fprintf(stderr, "kernel_launch: occupancy query says %d\n", per_cu); per_cu = 1; }
        (void)hipGetLastError();
        grid = cus * 1;
        fprintf(stderr, "kernel_launch: grid %d (cus %d, occupancy %d)\n", grid, cus, per_cu);
    }
    if (grid < 0) return;
    Args a{};
    for (int i = 0; i < 23; ++i) a.in[i] = (const float*)d_in[i];
    a.out = (float*)d_out; a.ws = (unsigned char*)d_ws;
    for (int i = 0; i < 8; ++i) a.invf[i] = (float)std::pow(500000.0, -(double)i / 8.0);
    void* kargs[] = {&a};
    hipError_t e = hipLaunchCooperativeKernel((const void*)fwd_megakernel, dim3(grid), dim3(NWAVES * 64), kargs, LDS_BYTES, stream);
    if (e != hipSuccess) fprintf(stderr, "kernel_launch: cooperative launch failed: %s (grid %d)\n", hipGetErrorString(e), grid);
}
```

```cpp
#include <hip/hip_runtime.h>
#include <hip/hip_cooperative_groups.h>
#include <cstdio>
#include <cstdint>
#include <cmath>
namespace cg = cooperative_groups;

__device__ __forceinline__ int opaque_tid() { int t = threadIdx.x; asm volatile("" : "+v"(t)); return t; }

namespace pg8 {
#define PG8_LAS __attribute__((address_space(3)))
typedef unsigned short bf16_t;
typedef short bf16x8 __attribute__((ext_vector_type(8)));
typedef float f32x4 __attribute__((ext_vector_type(4)));
typedef unsigned u32x4 __attribute__((ext_vector_type(4)));
constexpr int BM = 256, BK = 64, HALF = 128, HTB = HALF * BK * 2  , STAGE_BYTES = 8 * HTB, NXCD = 8, WGM = 8;

__host__ __device__ __forceinline__ int lds_byte(int r, int c) { const int st = (r >> 4) * 2 + (c >> 5), rr = r & 15, cc = c & 31, ob = rr * 64 + cc * 2; return st * 1024 + (ob ^ (((ob >> 9) & 1) << 5)); }
__host__ __device__ __forceinline__ void stage_rc(int b, int& R, int& C) { const int st = b / 1024, sb = b % 1024, swz = sb ^ (((sb >> 9) & 1) << 5); R = (st >> 1) * 16 + swz / 64; C = (st & 1) * 32 + (swz % 64) / 2; }
__host__ __device__ __forceinline__ int perm32(int rho) { const int n = rho >> 4, i = rho & 15; return 8 * (i >> 2) + 4 * n + (i & 3); }

struct Unit { int pm, pn; };
struct Gemm { const bf16_t* A; const bf16_t* Bt; int M, N, K; };

struct StaticOrder {
    int nM, nN, nwg, G, c;
    __host__ __device__ void init(int M, int N, int G_, int c_) { nM = M / BM; nN = N / BM; nwg = nM * nN; G = G_; c = c_; }
    __host__ __device__ bool next(int i, Unit& u) const {
        const long L = (long)i * G + c; if (L >= nwg) return false;
        int wgid = (int)L; { const int q = nwg / NXCD, r = nwg % NXCD, xcd = wgid % NXCD, off = wgid / NXCD; wgid = (xcd < r ? xcd * (q + 1) : r * (q + 1) + (xcd - r) * q) + off; }
        const int nig = WGM * nN, gid = wgid / nig, fm = gid * WGM, gsz = (nM - fm) < WGM ? (nM - fm) : WGM;
        u.pm = fm + ((wgid % nig) % gsz); u.pn = (wgid % nig) / gsz; return true;
    }
    __device__ __forceinline__ void a_ready(const Unit&) const {}
    __device__ __forceinline__ void done(const Unit&) const {}
};

typedef float f32x2v __attribute__((ext_vector_type(2))); typedef __bf16 bf16x2v __attribute__((ext_vector_type(2)));
__device__ __forceinline__ unsigned cvt_pk_bf16(float lo, float hi) { f32x2v v = {lo, hi}; bf16x2v b = __builtin_convertvector(v, bf16x2v); return __builtin_bit_cast(unsigned, b); }
__device__ __forceinline__ u32x4 pack8(const f32x4& v0, const f32x4& v1) { u32x4 w; w.x = cvt_pk_bf16(v0[0], v0[1]); w.y = cvt_pk_bf16(v0[2], v0[3]); w.z = cvt_pk_bf16(v1[0], v1[1]); w.w = cvt_pk_bf16(v1[2], v1[3]); return w; }

constexpr int MROWS = 32768;
constexpr float C2 = 0.125f * 1.4426950408889634f;
constexpr float RMS_EPS = 1e-6f;

__device__ __forceinline__ float row_inv_rms(const float* ssp, int row) {
    const f32x4* p = (const f32x4*)(ssp + (size_t)row * 16);
    const f32x4 a = p[0], b = p[1], c = p[2], d = p[3];
    const float s = ((a[0] + a[1]) + (a[2] + a[3])) + ((b[0] + b[1]) + (b[2] + b[3])) + ((c[0] + c[1]) + (c[2] + c[3])) + ((d[0] + d[1]) + (d[2] + d[3]));
    return 1.0f / sqrtf(s * (1.0f / 1024.0f) + RMS_EPS);
}

struct EpiIn {
    static constexpr bool PERM = true, AFTER_DRAIN = false;
    bf16_t* Z; const float* rope;
    __device__ __forceinline__ void operator()(const f32x4 (&acc)[2][2][4][2], const Unit& u, int wr, int wc, int fr, int fq) const {
        const int sec = u.pn >> 1;
        bf16_t* base = Z + (size_t)sec * MROWS * 512;
        const int cs0 = (u.pn & 1) * 256 + wc * 32 + 8 * fq;
        const int row0 = u.pm * BM + wr * 64 + fr;
        const bool ropew = (sec == 1 || sec == 2) && ((wc & 1) == 0);
        const float sc = (sec == 1) ? C2 : 1.0f;
#pragma unroll
        for (int ai = 0; ai < 2; ++ai)
#pragma unroll
            for (int m = 0; m < 4; ++m) {
                const int row = row0 + ai * HALF + m * 16; const int pos = row & 8191;
                f32x4 c0 = {1.f, 1.f, 1.f, 1.f}, c1 = c0, s0 = {0.f, 0.f, 0.f, 0.f}, s1 = s0;
                if (ropew) { const f32x4* cp = (const f32x4*)(rope + (size_t)pos * 8); const f32x4* sp = (const f32x4*)(rope + 65536 + (size_t)pos * 8); c0 = cp[0]; c1 = cp[1]; s0 = sp[0]; s1 = sp[1]; }
#pragma unroll
                for (int bj = 0; bj < 2; ++bj) {
                    f32x4 v0 = acc[ai][bj][m][0], v1 = acc[ai][bj][m][1];
                    if (ropew) {
                        f32x4 p0, p1;
#pragma unroll
                        for (int e = 0; e < 4; ++e) { p0[e] = __shfl_xor(v0[e], 16); p1[e] = __shfl_xor(v1[e], 16); }
                        if (fq == 0) { v0 = v0 * c0 - p0 * s0; v1 = v1 * c1 - p1 * s1; }
                        else if (fq == 1) { v0 = v0 * c0 + p0 * s0; v1 = v1 * c1 + p1 * s1; }
                    }
                    v0 = v0 * sc; v1 = v1 * sc;
                    *(u32x4*)(base + (size_t)row * 512 + cs0 + bj * HALF) = pack8(v0, v1);
                }
            }
    }
};

struct EpiRes {
    static constexpr bool PERM = true, AFTER_DRAIN = false;
    const float* R; float* H; bf16_t* HB; const float* bias; float* ssp;
    __device__ __forceinline__ void operator()(const f32x4 (&acc)[2][2][4][2], const Unit& u, int wr, int wc, int fr, int fq) const {
        const int row0 = u.pm * BM + wr * 64 + fr, col0 = u.pn * BM + wc * 32 + 8 * fq;
        f32x4 bv[2][2];
#pragma unroll
        for (int bj = 0; bj < 2; ++bj)
#pragma unroll
            for (int n = 0; n < 2; ++n) bv[bj][n] = bias ? *(const f32x4*)(bias + col0 + bj * HALF + 4 * n) : (f32x4){0.f, 0.f, 0.f, 0.f};
#pragma unroll
        for (int ai = 0; ai < 2; ++ai)
#pragma unroll
            for (int m = 0; m < 4; ++m) {
                const int row = row0 + ai * HALF + m * 16; float ss = 0.f;
#pragma unroll
                for (int bj = 0; bj < 2; ++bj) {
                    const size_t off = (size_t)row * 1024 + col0 + bj * HALF;
                    const f32x4 r0 = *(const f32x4*)(R + off), r1 = *(const f32x4*)(R + off + 4);
                    const f32x4 v0 = acc[ai][bj][m][0] + bv[bj][0] + r0, v1 = acc[ai][bj][m][1] + bv[bj][1] + r1;
                    *(f32x4*)(H + off) = v0; *(f32x4*)(H + off + 4) = v1;
                    if (HB) *(u32x4*)(HB + off) = pack8(v0, v1);
                    ss += (v0[0] * v0[0] + v0[1] * v0[1]) + (v0[2] * v0[2] + v0[3] * v0[3]) + (v1[0] * v1[0] + v1[1] * v1[1]) + (v1[2] * v1[2] + v1[3] * v1[3]);
                }
                ss += __shfl_xor(ss, 16); ss += __shfl_xor(ss, 32);
                if (fq == 0) ssp[(size_t)row * 16 + u.pn * 4 + wc] = ss;
                asm volatile("" ::: "memory");
            }
    }
};

struct EpiUp {
    static constexpr bool PERM = true, AFTER_DRAIN = false;
    bf16_t* O; const float* ssp;
    __device__ __forceinline__ void operator()(const f32x4 (&acc)[2][2][4][2], const Unit& u, int wr, int wc, int fr, int fq) const {
        const int row0 = u.pm * BM + wr * 64 + fr, col0 = u.pn * BM + wc * 32 + 8 * fq;
#pragma unroll
        for (int ai = 0; ai < 2; ++ai)
#pragma unroll
            for (int m = 0; m < 4; ++m) {
                const int row = row0 + ai * HALF + m * 16; const float s = row_inv_rms(ssp, row);
#pragma unroll
                for (int bj = 0; bj < 2; ++bj) {
                    f32x4 v0 = acc[ai][bj][m][0] * s, v1 = acc[ai][bj][m][1] * s;
#pragma unroll
                    for (int e = 0; e < 4; ++e) { const float a = fmaxf(v0[e], 0.f), b = fmaxf(v1[e], 0.f); v0[e] = a * a; v1[e] = b * b; }
                    *(u32x4*)(O + (size_t)row * 4096 + col0 + bj * HALF) = pack8(v0, v1);
                }
                asm volatile("" ::: "memory");
            }
    }
};

struct EpiGlu {
    static constexpr bool PERM = true, AFTER_DRAIN = false;
    bf16_t* O; const float* ssp; const float* bias;
    __device__ __forceinline__ void operator()(const f32x4 (&acc)[2][2][4][2], const Unit& u, int wr, int wc, int fr, int fq) const {
        const int row0 = u.pm * BM + wr * 64 + fr, col0 = u.pn * HALF + wc * 32 + 8 * fq;
        const f32x4 bv0 = *(const f32x4*)(bias + col0), bv1 = *(const f32x4*)(bias + col0 + 4), bg0 = *(const f32x4*)(bias + 1024 + col0), bg1 = *(const f32x4*)(bias + 1024 + col0 + 4);
#pragma unroll
        for (int ai = 0; ai < 2; ++ai)
#pragma unroll
            for (int m = 0; m < 4; ++m) {
                const int row = row0 + ai * HALF + m * 16; const float s = row_inv_rms(ssp, row);
                f32x4 a0 = acc[ai][0][m][0] * s + bv0, a1 = acc[ai][0][m][1] * s + bv1;
                const f32x4 g0 = acc[ai][1][m][0] * s + bg0, g1 = acc[ai][1][m][1] * s + bg1;
#pragma unroll
                for (int e = 0; e < 4; ++e) {
                    a0[e] = a0[e] * __builtin_amdgcn_rcpf(1.0f + __builtin_amdgcn_exp2f(-1.4426950408889634f * g0[e]));
                    a1[e] = a1[e] * __builtin_amdgcn_rcpf(1.0f + __builtin_amdgcn_exp2f(-1.4426950408889634f * g1[e]));
                }
                *(u32x4*)(O + (size_t)row * 1024 + col0) = pack8(a0, a1);
                asm volatile("" ::: "memory");
            }
    }
};

template <class Epi, class Sched, bool ALIGN_EPI = false, bool SP2 = false>
__device__ __forceinline__ void gemm_phase(PG8_LAS unsigned char* lds, const Gemm g, const Sched& S, const Epi& E) {
    const int tid = opaque_tid(), wid = __builtin_amdgcn_readfirstlane(tid >> 6), lane = tid & 63, wr = wid >> 2, wc = wid & 3, fr = lane & 15, fq = lane >> 4;
    const int K = g.K, nt = K / BK;
    unsigned voffA[2], voffB[2];
#pragma unroll
    for (int i = 0; i < 2; ++i) { int R, C; stage_rc(tid * 16 + i * 8192, R, C); const int Rb = Epi::PERM ? ((R & ~31) + perm32(R & 31)) : R;
        voffA[i] = (unsigned)(R * K + C) * 2u; voffB[i] = (unsigned)(Rb * K + C) * 2u; }
    const size_t kstep = (size_t)(BK * 2);
    const size_t hstep = (size_t)HALF * K * 2;
    const size_t tstep = 2 * hstep;
    const unsigned ldsw = (unsigned)wid * 1024u;
    const int aoff = lds_byte(wr * 64 + fr, fq * 8), boff = lds_byte(wc * 32 + fr, fq * 8);
#define PG8_SA(b, h) (((b) * 2 + (h)) * HTB)
#define PG8_SB(b, h) ((4 + (b) * 2 + (h)) * HTB)
#define PG8_STAGE(bufoff, gbase, voff) do { _Pragma("unroll") for (int _i = 0; _i < 2; ++_i) \
        __builtin_amdgcn_global_load_lds((const unsigned*)((const char*)(gbase) + (voff)[_i]), (PG8_LAS unsigned*)(lds + (bufoff) + ldsw + _i * 8192), 16, 0, 0); } while (0)
#define PG8_LDA(dst, b, h) do { _Pragma("unroll") for (int m = 0; m < 4; ++m) _Pragma("unroll") for (int k = 0; k < 2; ++k) dst[m][k] = *(const PG8_LAS bf16x8*)(lds + PG8_SA(b, h) + aoff + m * 2048 + k * 1024); } while (0)
#define PG8_LDB(dst, b, h) do { _Pragma("unroll") for (int n = 0; n < 2; ++n) _Pragma("unroll") for (int k = 0; k < 2; ++k) dst[n][k] = *(const PG8_LAS bf16x8*)(lds + PG8_SB(b, h) + boff + n * 2048 + k * 1024); } while (0)
#define PG8_MMA(ai, bj, At, Bt) do { __builtin_amdgcn_s_setprio(1); _Pragma("unroll") for (int m = 0; m < 4; ++m) _Pragma("unroll") for (int n = 0; n < 2; ++n) _Pragma("unroll") for (int k = 0; k < 2; ++k) \
        acc[ai][bj][m][n] = __builtin_amdgcn_mfma_f32_16x16x32_bf16(Bt[n][k], At[m][k], acc[ai][bj][m][n], 0, 0, 0); __builtin_amdgcn_s_setprio(0); } while (0)
#define PG8_WAIT_V(n) asm volatile("s_waitcnt vmcnt(" #n ")" ::: "memory")
#define PG8_WAIT_L(n) asm volatile("s_waitcnt lgkmcnt(" #n ")" ::: "memory")
#define PG8_BAR __builtin_amdgcn_s_barrier()
#define PG8_SCHED __builtin_amdgcn_sched_barrier(0)
    Unit cur, nxt; int ui = 0;
    if (!S.next(0, cur)) return;
    f32x4 acc[2][2][4][2];
#pragma unroll
    for (int a = 0; a < 2; ++a)
#pragma unroll
        for (int b = 0; b < 2; ++b)
#pragma unroll
            for (int m = 0; m < 4; ++m)
#pragma unroll
                for (int n = 0; n < 2; ++n) acc[a][b][m][n] = (f32x4){0.f, 0.f, 0.f, 0.f};
    bf16x8 At[4][2], B0[2][2], B1[2][2];
    const char* cA = (const char*)g.A + (size_t)cur.pm * tstep; const char* cB = (const char*)g.Bt + (size_t)cur.pn * tstep;
    S.a_ready(cur);
    if constexpr (SP2) {
        PG8_STAGE(PG8_SB(0, 0), cB, voffB); PG8_STAGE(PG8_SB(0, 1), cB + hstep, voffB); PG8_STAGE(PG8_SA(0, 0), cA, voffA); PG8_STAGE(PG8_SA(0, 1), cA + hstep, voffA);
        if (wr == 1) PG8_BAR;
        PG8_WAIT_V(2); PG8_BAR;
        PG8_STAGE(PG8_SB(1, 0), cB + kstep, voffB); PG8_STAGE(PG8_SA(1, 0), cA + kstep, voffA); PG8_STAGE(PG8_SB(1, 1), cB + hstep + kstep, voffB);
        PG8_WAIT_V(6); PG8_BAR;
    } else {
        PG8_STAGE(PG8_SB(0, 0), cB, voffB); PG8_STAGE(PG8_SA(0, 0), cA, voffA); PG8_STAGE(PG8_SB(0, 1), cB + hstep, voffB); PG8_STAGE(PG8_SA(0, 1), cA + hstep, voffA);
        if (wr == 1) PG8_BAR;
        PG8_WAIT_V(4); PG8_BAR;
        PG8_STAGE(PG8_SB(1, 0), cB + kstep, voffB); PG8_STAGE(PG8_SA(1, 0), cA + kstep, voffA); PG8_STAGE(PG8_SB(1, 1), cB + hstep + kstep, voffB);
        PG8_WAIT_V(6); PG8_BAR;
    }
    for (;;) {
        const bool has_next = S.next(ui + 1, nxt);
        const char* nA = has_next ? (const char*)g.A + (size_t)nxt.pm * tstep : cA; const char* nB = has_next ? (const char*)g.Bt + (size_t)nxt.pn * tstep : cB;
        for (int t = 0; t < nt; t += 2) {
            const bool last = (t == nt - 2);
            const char* a1 = cA + (size_t)(t + 1) * kstep;
            const char* a2 = last ? nA : cA + (size_t)(t + 2) * kstep; const char* b2 = last ? nB : cB + (size_t)(t + 2) * kstep;
            const char* a3 = a2 + kstep; const char* b3 = b2 + kstep;
            if (last && has_next) S.a_ready(nxt);
            if constexpr (SP2) {
            PG8_LDB(B0, 0, 0); PG8_LDB(B1, 0, 1); PG8_SCHED; PG8_LDA(At, 0, 0); PG8_STAGE(PG8_SA(1, 1), a1 + hstep, voffA);
            PG8_WAIT_V(8); PG8_WAIT_L(0); PG8_BAR; PG8_MMA(0, 0, At, B0); PG8_MMA(0, 1, At, B1); PG8_BAR; PG8_SCHED;
            PG8_LDA(At, 0, 1); PG8_STAGE(PG8_SB(0, 0), b2, voffB); PG8_STAGE(PG8_SB(0, 1), b2 + hstep, voffB); PG8_STAGE(PG8_SA(0, 0), a2, voffA);
            PG8_WAIT_V(8); PG8_WAIT_L(0); PG8_BAR; PG8_MMA(1, 0, At, B0); PG8_MMA(1, 1, At, B1); PG8_BAR; PG8_SCHED;
            PG8_LDB(B0, 1, 0); PG8_LDB(B1, 1, 1); PG8_SCHED; PG8_LDA(At, 1, 0); PG8_STAGE(PG8_SA(0, 1), a2 + hstep, voffA);
            PG8_WAIT_V(8); PG8_WAIT_L(0); PG8_BAR; PG8_MMA(0, 0, At, B0); PG8_MMA(0, 1, At, B1); PG8_BAR; PG8_SCHED;
            PG8_LDA(At, 1, 1); PG8_STAGE(PG8_SB(1, 0), b3, voffB); PG8_STAGE(PG8_SB(1, 1), b3 + hstep, voffB); PG8_STAGE(PG8_SA(1, 0), a3, voffA);
            PG8_WAIT_V(8); PG8_WAIT_L(0); PG8_BAR; PG8_MMA(1, 0, At, B0); PG8_MMA(1, 1, At, B1); PG8_BAR; PG8_SCHED;
            } else {
            PG8_LDB(B0, 0, 0); PG8_SCHED; PG8_LDA(At, 0, 0); PG8_STAGE(PG8_SA(1, 1), a1 + hstep, voffA);
            PG8_WAIT_L(8); PG8_BAR; PG8_WAIT_L(0); PG8_MMA(0, 0, At, B0); PG8_BAR; PG8_SCHED;
            PG8_LDB(B1, 0, 1); PG8_STAGE(PG8_SB(0, 0), b2, voffB);
            PG8_BAR; PG8_WAIT_L(0); PG8_MMA(0, 1, At, B1); PG8_BAR;
            PG8_LDA(At, 0, 1); PG8_STAGE(PG8_SA(0, 0), a2, voffA);
            PG8_BAR; PG8_WAIT_L(0); PG8_MMA(1, 0, At, B0); PG8_BAR; PG8_SCHED;
            PG8_STAGE(PG8_SB(0, 1), b2 + hstep, voffB);
            PG8_WAIT_V(6); PG8_BAR; PG8_MMA(1, 1, At, B1); PG8_BAR;
            PG8_LDB(B0, 1, 0); PG8_SCHED; PG8_LDA(At, 1, 0); PG8_STAGE(PG8_SA(0, 1), a2 + hstep, voffA);
            PG8_WAIT_L(8); PG8_BAR; PG8_WAIT_L(0); PG8_MMA(0, 0, At, B0); PG8_BAR; PG8_SCHED;
            PG8_LDB(B1, 1, 1); PG8_STAGE(PG8_SB(1, 0), b3, voffB);
            PG8_BAR; PG8_WAIT_L(0); PG8_MMA(0, 1, At, B1); PG8_BAR;
            PG8_LDA(At, 1, 1); PG8_STAGE(PG8_SA(1, 0), a3, voffA);
            PG8_BAR; PG8_WAIT_L(0); PG8_MMA(1, 0, At, B0); PG8_BAR; PG8_SCHED;
            PG8_STAGE(PG8_SB(1, 1), b3 + hstep, voffB);
            PG8_WAIT_V(6); PG8_BAR; PG8_MMA(1, 1, At, B1); PG8_BAR;
            }
        }
        if constexpr (ALIGN_EPI) { if (wr == 0) PG8_BAR; }
        if constexpr (!Epi::AFTER_DRAIN) { E(acc, cur, wr, wc, fr, fq); S.done(cur); }
        if (!has_next) break;
#pragma unroll
        for (int a = 0; a < 2; ++a)
#pragma unroll
            for (int b = 0; b < 2; ++b)
#pragma unroll
                for (int m = 0; m < 4; ++m)
#pragma unroll
                    for (int n = 0; n < 2; ++n) acc[a][b][m][n] = (f32x4){0.f, 0.f, 0.f, 0.f};
        cur = nxt; cA = nA; cB = nB; ++ui;
        if constexpr (ALIGN_EPI) { if (wr == 1) PG8_BAR; }
    }
    PG8_WAIT_V(0);
    if constexpr (!ALIGN_EPI) { if (wr == 0) PG8_BAR; }
    PG8_BAR;
    if constexpr (Epi::AFTER_DRAIN) { E.fused(acc, cur, wr, wc, fr, fq, lds, wid, lane); S.done(cur); }
#undef PG8_SA
#undef PG8_SB
#undef PG8_STAGE
#undef PG8_LDA
#undef PG8_LDB
#undef PG8_MMA
#undef PG8_WAIT_V
#undef PG8_WAIT_L
#undef PG8_BAR
#undef PG8_SCHED
}
}

#define LAS __attribute__((address_space(3)))
typedef unsigned short bf16;
typedef unsigned u32x4 __attribute__((ext_vector_type(4)));
typedef unsigned u32x2 __attribute__((ext_vector_type(2)));
typedef float f32x4 __attribute__((ext_vector_type(4)));
typedef float f32x2 __attribute__((ext_vector_type(2)));
typedef float f32x16 __attribute__((ext_vector_type(16)));
typedef short bf16x8 __attribute__((ext_vector_type(8)));
typedef short s16x4 __attribute__((ext_vector_type(4)));
#define LDS_WAIT() asm volatile("s_waitcnt lgkmcnt(0)" ::: "memory")

constexpr int NWAVES = 8;
constexpr int BATCH = 4, SEQ = 8192, DM = 1024, M = BATCH * SEQ, DFF = 4096, INW = 2048;
constexpr int LDS_BYTES = 147456, MISC_OFF = 147200;
constexpr size_t MiB = 1u << 20;
constexpr size_t WS_CTL = 0;
constexpr size_t WS_WIN = 1 * MiB;
constexpr size_t WS_WCAT = 5 * MiB;
constexpr size_t WS_WUP = 7 * MiB;
constexpr size_t WS_WDN = 23 * MiB;
constexpr size_t WS_PW1 = 39 * MiB;
constexpr size_t WS_PW2 = 43 * MiB;
constexpr size_t WS_ROPE = 45 * MiB;
constexpr size_t WS_SSP = 46 * MiB;
constexpr size_t WS_AB = 48 * MiB;
constexpr size_t WS_BIG = 112 * MiB;
constexpr size_t WS_Z = WS_BIG, WS_CAT = WS_BIG + 128 * MiB, WS_HID = WS_BIG, WS_G = WS_BIG, WS_Y = WS_BIG + 64 * MiB;
constexpr size_t WS_END = WS_BIG + 256 * MiB;

__device__ __forceinline__ unsigned pk2(float lo, float hi) { return pg8::cvt_pk_bf16(lo, hi); }
__device__ __forceinline__ float bflo(unsigned v) { return __uint_as_float(v << 16); }
__device__ __forceinline__ float bfhi(unsigned v) { return __uint_as_float(v & 0xffff0000u); }
__device__ __forceinline__ float wave_sum(float v) {
#pragma unroll
    for (int o = 1; o < 64; o <<= 1) v += __shfl_xor(v, o);
    return v;
}

__device__ __forceinline__ void tr_item(const float* W, int ldw, int k0, int n0, const float* gain, bf16* WT, int ldt, int drow0, LAS float* scr, int lane) {
#pragma unroll 8
    for (int i = 0; i < 32; ++i) { const int kk = 2 * i + (lane >> 5); const float g = gain ? gain[k0 + kk] : 1.0f; scr[kk * 33 + (lane & 31)] = W[(size_t)(k0 + kk) * ldw + n0 + (lane & 31)] * g; }
    LDS_WAIT();
    const int c = lane & 7;
#pragma unroll
    for (int j = 0; j < 4; ++j) { const int n = (lane >> 3) + 8 * j; const LAS float* s = scr + (8 * c) * 33 + n;
        u32x4 o; o.x = pk2(s[0 * 33], s[1 * 33]); o.y = pk2(s[2 * 33], s[3 * 33]); o.z = pk2(s[4 * 33], s[5 * 33]); o.w = pk2(s[6 * 33], s[7 * 33]);
        *(u32x4*)(WT + (size_t)(drow0 + n) * ldt + k0 + 8 * c) = o; }
    LDS_WAIT();
}
__device__ __forceinline__ void tr_matrix_item(const float* W, int K, int N, int kbase, const float* gain, bf16* WT, int ldt, int item, bool glu, LAS float* scr, int lane) {
    const int nblk = N / 32, kb = item / nblk, nb = item % nblk; const int k0 = kbase + 64 * kb, n0 = 32 * nb;
    int drow0 = n0;
    if (glu) { const int half = n0 >= 1024 ? 1 : 0, j = n0 - half * 1024; drow0 = 256 * (j >> 7) + 128 * half + (j & 127); }
    tr_item(W, N, k0, n0, gain, WT, ldt, drow0, scr, lane);
}

struct Args {
    const float* in[23]; float* out; unsigned char* ws; float invf[8]; int use_cg; int pad;
};

__device__ __forceinline__ void prologue(const Args& a, LAS unsigned char* lds, int vcu, int G, int wave, int lane) {
    unsigned char* ws = a.ws;
    LAS float* scr = (LAS float*)(lds + wave * 16384);
    const int gw = vcu * NWAVES + wave, NGW = G * NWAVES;
    const float* x = a.in[0]; const float* mix_norm = a.in[1]; const float* mlp_norm = a.in[2]; const float* w_up = a.in[3]; const float* w_down = a.in[4];
    const float* w_in = a.in[6]; const float* pool_w = a.in[7]; const float* pool_scale = a.in[8]; const float* w_out = a.in[14];
    const float* pw1 = a.in[15]; const float* pw2 = a.in[21];
    bf16* WIN = (bf16*)(ws + WS_WIN); bf16* WCAT = (bf16*)(ws + WS_WCAT); bf16* WUP = (bf16*)(ws + WS_WUP); bf16* WDN = (bf16*)(ws + WS_WDN);
    bf16* PW1 = (bf16*)(ws + WS_PW1); bf16* PW2 = (bf16*)(ws + WS_PW2);
    constexpr int I_IN = 16 * 64, I_OUT = 8 * 32, I_UP = 16 * 128, I_DN = 64 * 32, I_PW1 = 16 * 64, I_PW2 = 16 * 32;
    constexpr int NITEMS = I_IN + I_OUT + 2 * I_UP + 2 * I_DN + I_PW1 + I_PW2;
    for (int it = gw; it < NITEMS; it += NGW) {
        int r = it;
        if (r < I_IN) { tr_matrix_item(w_in, 1024, 2048, 0, nullptr, WIN, 1024, r, false, scr, lane); continue; } r -= I_IN;
        if (r < I_OUT) { tr_matrix_item(w_out, 512, 1024, 512, nullptr, WCAT, 1024, r, false, scr, lane); continue; } r -= I_OUT;
        if (r < I_UP) { tr_matrix_item(w_up, 1024, 4096, 0, mlp_norm, WUP, 1024, r, false, scr, lane); continue; } r -= I_UP;
        if (r < I_UP) { tr_matrix_item(w_up + (size_t)1024 * 4096, 1024, 4096, 0, mlp_norm + 1024, WUP + (size_t)4096 * 1024, 1024, r, false, scr, lane); continue; } r -= I_UP;
        if (r < I_DN) { tr_matrix_item(w_down, 4096, 1024, 0, nullptr, WDN, 4096, r, false, scr, lane); continue; } r -= I_DN;
        if (r < I_DN) { tr_matrix_item(w_down + (size_t)4096 * 1024, 4096, 1024, 0, nullptr, WDN + (size_t)1024 * 4096, 4096, r, false, scr, lane); continue; } r -= I_DN;
        if (r < I_PW1) { tr_matrix_item(pw1, 1024, 2048, 0, mix_norm + 1024, PW1, 1024, r, true, scr, lane); continue; } r -= I_PW1;
        tr_matrix_item(pw2, 1024, 1024, 0, nullptr, PW2, 1024, r, false, scr, lane);
    }
    for (int it = gw; it < 16 * 64; it += NGW) {
        const int nb = it & 15, kb = it >> 4; const int n = nb * 64 + lane, k0 = kb * 8, g = k0 >> 7;
        float acc8[8];
#pragma unroll
        for (int i = 0; i < 8; ++i) acc8[i] = 0.f;
        for (int d = 0; d < 128; ++d) {
            const float wv = w_out[(size_t)(g * 128 + d) * 1024 + n] * pool_scale[g * 128 + d];
#pragma unroll
            for (int i = 0; i < 8; ++i) acc8[i] += pool_w[(size_t)(k0 + i) * 128 + d] * wv;
        }
        u32x4 o; o.x = pk2(acc8[0], acc8[1]); o.y = pk2(acc8[2], acc8[3]); o.z = pk2(acc8[4], acc8[5]); o.w = pk2(acc8[6], acc8[7]);
        *(u32x4*)(WCAT + (size_t)n * 1024 + k0) = o;
    }
    {
        float* rope = (float*)(ws + WS_ROPE);
        const int gt = (vcu * NWAVES + wave) * 64 + lane, NGT = NGW * 64;
        for (int idx = gt; idx < 8192 * 8; idx += NGT) {
            const int pos = idx >> 3, i = idx & 7;
            const float angf = (float)pos * a.invf[i];
            const double ang = (double)angf;
            const double n = __builtin_rint(ang * 0.15915494309189535);
            const double y = ang - n * 6.283185307179586476925;
            const double y2 = y * y;
            double sp = 1.0, cp = 1.0;
#pragma unroll
            for (int k = 13; k >= 1; --k) { sp = 1.0 - sp * y2 / (double)((2 * k) * (2 * k + 1)); cp = 1.0 - cp * y2 / (double)((2 * k - 1) * (2 * k)); }
            rope[idx] = (float)cp; rope[65536 + idx] = (float)(y * sp);
        }
    }
    {
        bf16* XN = (bf16*)(ws + WS_AB);
        f32x4 gv[4];
#pragma unroll
        for (int j = 0; j < 4; ++j) gv[j] = ((const f32x4*)mix_norm)[lane + 64 * j];
        for (int m = gw; m < M; m += NGW) {
            const f32x4* xr = (const f32x4*)(x + (size_t)m * DM) + lane;
            f32x4 v[4]; float s = 0.f;
#pragma unroll
            for (int j = 0; j < 4; ++j) { v[j] = xr[64 * j]; s += (v[j][0] * v[j][0] + v[j][1] * v[j][1]) + (v[j][2] * v[j][2] + v[j][3] * v[j][3]); }
            const float inv = 1.0f / sqrtf(wave_sum(s) * (1.0f / DM) + 1e-6f);
            u32x2* o8 = (u32x2*)(XN + (size_t)m * DM) + lane;
#pragma unroll
            for (int j = 0; j < 4; ++j) { u32x2 o; o.x = pk2(v[j][0] * inv * gv[j][0], v[j][1] * inv * gv[j][1]); o.y = pk2(v[j][2] * inv * gv[j][2], v[j][3] * inv * gv[j][3]); o8[64 * j] = o; }
        }
    }
}

template <int W> __device__ __forceinline__ void pool_item(const bf16* U, bf16* CAT, int row, int c8) {
    const int t = row & (SEQ - 1);
    u32x4 v[W];
#pragma unroll
    for (int j = 0; j < W; ++j) { const int rj = (j <= t) ? row - j : row; v[j] = *(const u32x4*)(U + (size_t)rj * 512 + c8 * 8); }
    float s[8];
#pragma unroll
    for (int e = 0; e < 8; ++e) s[e] = 0.f;
#pragma unroll
    for (int j = 0; j < W; ++j) { if (j <= t) { s[0] += bflo(v[j].x); s[1] += bfhi(v[j].x); s[2] += bflo(v[j].y); s[3] += bfhi(v[j].y); s[4] += bflo(v[j].z); s[5] += bfhi(v[j].z); s[6] += bflo(v[j].w); s[7] += bfhi(v[j].w); } }
    const float ic = 1.0f / (float)((t + 1 < W) ? (t + 1) : W);
    u32x4 o; o.x = pk2(s[0] * ic - bflo(v[0].x), s[1] * ic - bfhi(v[0].x)); o.y = pk2(s[2] * ic - bflo(v[0].y), s[3] * ic - bfhi(v[0].y));
    o.z = pk2(s[4] * ic - bflo(v[0].z), s[5] * ic - bfhi(v[0].z)); o.w = pk2(s[6] * ic - bflo(v[0].w), s[7] * ic - bfhi(v[0].w));
    *(u32x4*)(CAT + (size_t)row * 1024 + c8 * 8) = o;
}
__device__ __forceinline__ void pool_phase(const bf16* U, bf16* CAT, int vcu, int G, int tid) {
    const int gt = vcu * (NWAVES * 64) + tid, NGT = G * NWAVES * 64;
    for (int it = gt; it < M * 64; it += NGT) {
        const int row = it >> 6, c8 = it & 63; const int g = c8 >> 4;
        if (g == 0) pool_item<2>(U, CAT, row, c8); else if (g == 1) pool_item<4>(U, CAT, row, c8); else if (g == 2) pool_item<8>(U, CAT, row, c8); else pool_item<16>(U, CAT, row, c8);
    }
}

namespace att {
constexpr int KBUF = 0, VBUF = 49152, XOFF = 0, WSF = 98304, SLOT = 16384;
__device__ __forceinline__ int crow(int r, int hi) { return (r & 3) + 8 * (r >> 2) + 4 * hi; }
__device__ __forceinline__ void glds16(const void* gsrc, unsigned lds_dst) { unsigned keep;
    asm volatile("s_mov_b32 %0, m0\n\ts_mov_b32 m0, %2\n\ts_nop 0\n\tglobal_load_lds_dwordx4 %1, off\n\ts_mov_b32 m0, %0" : "=&s"(keep) : "v"(gsrc), "s"(lds_dst) : "memory"); }
typedef short v4i16_t __attribute__((ext_vector_type(4)));
__device__ __forceinline__ s16x4 vtr(LAS const unsigned char* p) { return __builtin_bit_cast(s16x4, __builtin_amdgcn_ds_read_tr16_b64_v4i16((LAS v4i16_t*)p)); }
#define MX3(a, b, c) __builtin_fmaxf(__builtin_fmaxf((a), (b)), (c))
#define MFMA32(a, b, c) __builtin_amdgcn_mfma_f32_32x32x16_bf16(a, b, c, 0, 0, 0)
#define SBAR() __builtin_amdgcn_sched_barrier(0)
#define PIN(x) asm volatile("" : "+v"(x))
constexpr float THR = 8.0f;

__device__ __forceinline__ bf16x8 vfrag(LAS const unsigned char* vp, int i) {
    const int off = (i & 3) * 4096 + (i >> 2) * 1024;
    const s16x4 lo = vtr(vp + off), hh = vtr(vp + off + 512);
    return (bf16x8){lo[0], lo[1], lo[2], lo[3], hh[0], hh[1], hh[2], hh[3]};
}
__device__ __forceinline__ bf16x8 kfrag(LAS const unsigned char* kp, int j) {
    return *(LAS const bf16x8*)(kp + (j >> 1) * 2048 + (j & 1) * 512);
}
#define SEL32(A, B, e) ((e) < 16 ? A[(e) & 15] : B[(e) & 15])

template <bool DO_PV, bool DO_QK, bool BAND>
__device__ __forceinline__ void step(f32x16& S0, f32x16& S1, f32x16& T0, f32x16& T1, f32x16 (&o)[4], u32x4 (&pw)[4], const bf16x8 (&qr)[4],
                                     float& mref, float& l, float& alpha, bool& resc, LAS const unsigned char* kp, LAS const unsigned char* vp, int jb, int qrel, int hi,
                                     const bf16* ks0, const bf16* ks1, const bf16* vs0, const bf16* vs1, unsigned kd0, unsigned kd1, unsigned vd0, unsigned vd1) {
    bf16x8 vf[16]; bf16x8 kf[8];
    if (DO_PV) { vf[0] = vfrag(vp, 0); vf[1] = vfrag(vp, 1); }
    if (BAND) {
        const int kb = 64 * jb + 4 * hi;
#pragma unroll
        for (int r = 0; r < 16; ++r) { const int kv = kb + (r & 3) + 8 * (r >> 2); if (kv > qrel) S0[r] = -INFINITY; if (kv + 32 > qrel) S1[r] = -INFINITY; }
    }
    SBAR();
    float ma = 0.f, mb = 0.f, rm = 0.f;
#pragma unroll
    for (int i = 0; i < 16; ++i) {
        if (DO_PV) { if (i + 2 < 16) vf[i + 2] = vfrag(vp, i + 2); o[i & 3] = MFMA32(__builtin_bit_cast(bf16x8, pw[i >> 2]), vf[i], o[i & 3]); }
        if (i == 0) { ma = MX3(S0[0], S0[1], S1[0]); mb = MX3(S0[2], S0[3], S1[1]); ma = MX3(ma, S1[2], S1[3]);
                      ma = MX3(ma, S0[4], S0[5]); mb = MX3(mb, S0[6], S0[7]); PIN(ma); PIN(mb); }
        else if (i == 1) { ma = MX3(ma, S1[4], S1[5]); mb = MX3(mb, S1[6], S1[7]); ma = MX3(ma, S0[8], S0[9]); mb = MX3(mb, S0[10], S0[11]); ma = MX3(ma, S1[8], S1[9]); PIN(ma); PIN(mb); }
        else if (i == 2) { mb = MX3(mb, S1[10], S1[11]); ma = MX3(ma, S0[12], S0[13]); mb = MX3(mb, S0[14], S0[15]); ma = MX3(ma, S1[12], S1[13]); mb = MX3(mb, S1[14], S1[15]);
                           rm = __builtin_fmaxf(ma, mb); PIN(rm); }
        else if (i == 3) {
            auto rr = __builtin_amdgcn_permlane32_swap(__float_as_uint(rm), __float_as_uint(rm), false, false);
            rm = __builtin_fmaxf(__uint_as_float(rr[0]), __uint_as_float(rr[1]));
            const bool grow = rm > mref + THR; const float mnew = grow ? rm : mref;
            alpha = __builtin_amdgcn_exp2f(mref - mnew); l *= alpha; mref = mnew; resc = __any(grow);
            PIN(mref); PIN(l);
        }
        if (i == 4) glds16(ks0, kd0); else if (i == 7) glds16(ks1, kd1); else if (i == 10) glds16(vs0, vd0); else if (i == 13) glds16(vs1, vd1);
        if (i >= 3) {
            const int e0 = ((i - 3) * 32) / 13, e1 = ((i - 2) * 32) / 13;
#pragma unroll
            for (int e = e0; e < e1; ++e) { if (e < 16) S0[e] = __builtin_amdgcn_exp2f(S0[e] - mref); else S1[e - 16] = __builtin_amdgcn_exp2f(S1[e - 16] - mref); }
            PIN(S0); PIN(S1);
        }
        SBAR();
    }
    if (DO_QK) { kf[0] = kfrag(kp, 0); kf[1] = kfrag(kp, 1); T0 = f32x16{}; T1 = f32x16{}; }
    float sacc = 0.f;
#pragma unroll
    for (int j = 0; j < 8; ++j) {
        if (DO_QK) { if (j + 2 < 8) kf[j + 2] = kfrag(kp, j + 2); if (j & 1) T1 = MFMA32(kf[j], qr[j >> 1], T1); else T0 = MFMA32(kf[j], qr[j >> 1], T0); }
        const int e = 4 * j;
        const float x0 = SEL32(S0, S1, e), x1 = SEL32(S0, S1, e + 1), x2 = SEL32(S0, S1, e + 2), x3 = SEL32(S0, S1, e + 3);
        sacc += x0; sacc += x1; sacc += x2; sacc += x3; PIN(sacc);
        const unsigned w0 = pk2(x0, x1), w1 = pk2(x2, x3);
        if (j & 1) { pw[j >> 1].z = w0; pw[j >> 1].w = w1; } else { pw[j >> 1].x = w0; pw[j >> 1].y = w1; }
        PIN(pw[j >> 1]);
        SBAR();
    }
    l += sacc;
}

__device__ __forceinline__ void attn_unit(int b, int h, int qb, const bf16* Q, const bf16* K, const bf16* V, bf16* CAT, const float* subln, float lam, LAS unsigned char* lds) {
    const int tid = opaque_tid(), lane = tid & 63, r32 = lane & 31, hi = lane >> 5; const int wid = __builtin_amdgcn_readfirstlane(tid >> 6);
    const int comp = wid >> 2, wq = wid & 3;
    const size_t rowbase = (size_t)b * SEQ; const int q0 = qb * 128; const int NT = (q0 + 128) / 64;
    const unsigned lds0 = (unsigned)(size_t)lds;
    LAS float* wsf = (LAS float*)(lds + WSF) + wid * 64;
    const bf16* Qw = Q + (rowbase + q0 + wq * 32 + r32) * 512 + h * 128 + comp * 64;
    bf16x8 qr[4];
#pragma unroll
    for (int d0 = 0; d0 < 4; ++d0) qr[d0] = *(const bf16x8*)(Qw + d0 * 16 + hi * 8);
    const bf16* ksrc[2]; const bf16* vsrc[2]; unsigned kdst[2], vdst[2];
#pragma unroll
    for (int i = 0; i < 2; ++i) { const int p = 2 * wid + i; const int kc = p >> 3, ch = p & 7, db = p >> 2, rg = p & 3;
        ksrc[i] = K + (rowbase + lane) * 512 + h * 128 + kc * 64 + ch * 8; kdst[i] = lds0 + KBUF + kc * 8192 + ch * 1024;
        vsrc[i] = V + (rowbase + 16 * rg + (lane >> 2)) * 512 + h * 128 + db * 32 + (lane & 3) * 8; vdst[i] = lds0 + VBUF + db * 4096 + rg * 1024; }
#define DMA_K(t) do { const unsigned so_ = (unsigned)(((t) % 3) * SLOT); _Pragma("unroll") for (int i_ = 0; i_ < 2; ++i_) glds16(ksrc[i_] + (size_t)(t) * 64 * 512, (unsigned)__builtin_amdgcn_readfirstlane(kdst[i_] + so_)); } while (0)
#define DMA_V(t) do { const unsigned so_ = (unsigned)(((t) % 3) * SLOT); _Pragma("unroll") for (int i_ = 0; i_ < 2; ++i_) glds16(vsrc[i_] + (size_t)(t) * 64 * 512, (unsigned)__builtin_amdgcn_readfirstlane(vdst[i_] + so_)); } while (0)
    f32x16 o[4];
#pragma unroll
    for (int d0 = 0; d0 < 4; ++d0) o[d0] = f32x16{};
    float mref = -INFINITY, l = 0.f, alpha = 1.f; bool resc = false;
    const int qrel = wq * 32 + r32;
    u32x4 pw[4];
#pragma unroll
    for (int k = 0; k < 4; ++k) pw[k] = (u32x4){0u, 0u, 0u, 0u};
    LAS const unsigned char* kbase = lds + KBUF + comp * 8192 + hi * 1024 + r32 * 16;
    LAS const unsigned char* vbase = lds + VBUF + ((lane >> 4) & 1) * 32 + (lane & 3) * 8 + (4 * hi + ((lane & 15) >> 2)) * 64;
    asm volatile("s_waitcnt vmcnt(0)" ::: "memory");
    DMA_K(0); DMA_V(0); DMA_K(1);
    { const int t2 = (2 < NT) ? 2 : NT - 1; _Pragma("unroll") for (int i_ = 0; i_ < 2; ++i_) glds16(ksrc[i_] + (size_t)t2 * 64 * 512, (unsigned)__builtin_amdgcn_readfirstlane(kdst[i_] + 2 * SLOT)); }
    asm volatile("s_waitcnt vmcnt(6)" ::: "memory");
    __builtin_amdgcn_s_barrier(); asm volatile("" ::: "memory");
    f32x16 SA = f32x16{}, SB = f32x16{}, TA, TB;
#pragma unroll
    for (int j = 0; j < 8; ++j) { const bf16x8 kf = kfrag(kbase, j); if (j & 1) SB = MFMA32(kf, qr[j >> 1], SB); else SA = MFMA32(kf, qr[j >> 1], SA); }
    asm volatile("s_waitcnt vmcnt(2) lgkmcnt(0)" ::: "memory");
    __builtin_amdgcn_s_barrier(); asm volatile("" ::: "memory");
#define ITER(DP, DQ, BD, S0_, S1_, T0_, T1_, t_, jb_) do { const int tt_ = (t_); \
        const int tk_ = (tt_ + 3 < NT) ? tt_ + 3 : NT - 1, tv_ = (tt_ + 1 < NT) ? tt_ + 1 : NT - 1;        \
        int ko_ = ((tt_ + 1) % 3) * SLOT, vo_ = ((tt_ + 2) % 3) * SLOT, kso_ = (tt_ % 3) * SLOT; asm volatile("" : "+s"(ko_), "+s"(vo_), "+s"(kso_));     \
        step<DP, DQ, BD>(S0_, S1_, T0_, T1_, o, pw, qr, mref, l, alpha, resc, kbase + ko_, vbase + vo_, (jb_), qrel, hi, \
            ksrc[0] + (size_t)tk_ * 64 * 512, ksrc[1] + (size_t)tk_ * 64 * 512, vsrc[0] + (size_t)tv_ * 64 * 512, vsrc[1] + (size_t)tv_ * 64 * 512, \
            (unsigned)__builtin_amdgcn_readfirstlane(kdst[0] + kso_), (unsigned)__builtin_amdgcn_readfirstlane(kdst[1] + kso_), \
            (unsigned)__builtin_amdgcn_readfirstlane(vdst[0] + ko_), (unsigned)__builtin_amdgcn_readfirstlane(vdst[1] + ko_)); \
        asm volatile("s_waitcnt vmcnt(4) lgkmcnt(0)" ::: "memory"); \
        __builtin_amdgcn_s_barrier(); asm volatile("" ::: "memory"); \
        if (resc) { if (hi == 0) wsf[r32] = alpha; LDS_WAIT(); \
            _Pragma("unroll") for (int r = 0; r < 16; ++r) { const float f_ = wsf[crow(r, hi)]; _Pragma("unroll") for (int d0 = 0; d0 < 4; ++d0) o[d0][r] *= f_; } } \
    } while (0)
    if (NT == 2) {
        ITER(false, true, true, SA, SB, TA, TB, 0, 0);
        ITER(true, false, true, TA, TB, SA, SB, 1, 1);
    } else {
        ITER(false, true, false, SA, SB, TA, TB, 0, 0);
        ITER(true, true, false, TA, TB, SA, SB, 1, 0);
        for (int t = 2; t < NT - 2; t += 2) {
            ITER(true, true, false, SA, SB, TA, TB, t, 0);
            ITER(true, true, false, TA, TB, SA, SB, t + 1, 0);
        }
        ITER(true, true, true, SA, SB, TA, TB, NT - 2, 0);
        ITER(true, false, true, TA, TB, SA, SB, NT - 1, 1);
    }
#undef ITER
    {
        int vo_ = ((NT - 1) % 3) * SLOT; asm volatile("" : "+s"(vo_));
        LAS const unsigned char* vp = vbase + vo_;
#pragma unroll
        for (int i = 0; i < 16; ++i) o[i & 3] = MFMA32(__builtin_bit_cast(bf16x8, pw[i >> 2]), vfrag(vp, i), o[i & 3]);
    }
    asm volatile("s_waitcnt vmcnt(0) lgkmcnt(0)" ::: "memory");
    __builtin_amdgcn_s_barrier(); asm volatile("" ::: "memory");
#undef DMA_K
#undef DMA_V
    const int tid2 = opaque_tid(), lane2 = tid2 & 63, r32b = lane2 & 31, hib = lane2 >> 5;
    LAS float* wsf2 = (LAS float*)(lds + WSF) + __builtin_amdgcn_readfirstlane(tid2 >> 6) * 64;
    { auto rr = __builtin_amdgcn_permlane32_swap(__float_as_uint(l), __float_as_uint(l), false, false); l = __uint_as_float(rr[0]) + __uint_as_float(rr[1]); }
    if (hib == 0) wsf2[r32b] = 1.0f / l;
    LDS_WAIT();
    float rli[16];
#pragma unroll
    for (int r = 0; r < 16; ++r) rli[r] = wsf2[crow(r, hib)];
    LAS float* X = (LAS float*)(lds + XOFF);
    if (comp == 1) {
#pragma unroll
        for (int d0 = 0; d0 < 4; ++d0)
#pragma unroll
            for (int r = 0; r < 16; ++r) X[((wq * 4 + d0) * 16 + r) * 64 + lane2] = lam * o[d0][r] * rli[r];
    }
    LDS_WAIT();
    __builtin_amdgcn_s_barrier(); asm volatile("" ::: "memory");
    if (comp == 0) {
        float ssq[16];
#pragma unroll
        for (int r = 0; r < 16; ++r) ssq[r] = 0.f;
#pragma unroll
        for (int d0 = 0; d0 < 4; ++d0)
#pragma unroll
            for (int r = 0; r < 16; ++r) { const float v = o[d0][r] * rli[r] - X[((wq * 4 + d0) * 16 + r) * 64 + lane2]; o[d0][r] = v; ssq[r] += v * v; }
#pragma unroll
        for (int r = 0; r < 16; ++r) {
            float s = ssq[r];
            s += __shfl_xor(s, 1); s += __shfl_xor(s, 2); s += __shfl_xor(s, 4); s += __shfl_xor(s, 8); s += __shfl_xor(s, 16);
            ssq[r] = 0.8f / sqrtf(s * (1.0f / 128.0f) + 1e-5f);
        }
        bf16* Ow = CAT + (rowbase + q0 + wq * 32) * 1024 + 512 + h * 128 + r32b;
#pragma unroll
        for (int d0 = 0; d0 < 4; ++d0) { const float gsub = subln[d0 * 32 + r32b];
#pragma unroll
            for (int r = 0; r < 16; ++r) { const float y = o[d0][r] * ssq[r] * gsub; Ow[(size_t)crow(r, hib) * 1024 + d0 * 32] = (bf16)(pk2(y, 0.f) & 0xffffu); } }
    }
    LDS_WAIT();
    __builtin_amdgcn_s_barrier(); asm volatile("" ::: "memory");
}
}

__device__ __forceinline__ void conv_phase(LAS unsigned char* lds, const bf16* Gt, bf16* Y, const float* dw_w, const float* dw_b, const float* ln_g, const float* ln_b, int vcu, int G) {
    const int tid = opaque_tid(), lane = tid & 63; const int wid = tid >> 6;
    const int c0 = 2 * tid;
    LAS float* red = (LAS float*)(lds + 62 * 2048);
    LAS float* mr = (LAS float*)(lds + 62 * 2048 + 2048);
    const f32x2 bia = *(const f32x2*)(dw_b + c0), gam = *(const f32x2*)(ln_g + c0), bet = *(const f32x2*)(ln_b + c0);
    for (int tile = vcu; tile < 1024; tile += G) {
        const int b = tile >> 8, t0 = (tile & 255) * 32;
        const float* dww = dw_w; asm volatile("" : "+s"(dww));
#pragma unroll 4
        for (int p = tid; p < 62 * 128; p += NWAVES * 64) {
            const int rr = p >> 7, pc = p & 127; const int t = t0 - 30 + rr; u32x4 v = {0u, 0u, 0u, 0u};
            if (t >= 0) v = *(const u32x4*)(Gt + ((size_t)b * SEQ + t) * 1024 + pc * 8);
            *(LAS u32x4*)(lds + rr * 2048 + pc * 16) = v;
        }
        __syncthreads();
        f32x2 av[32];
#pragma unroll
        for (int tt = 0; tt < 32; ++tt) av[tt] = bia;
#pragma unroll
        for (int half = 0; half < 2; ++half) {
            const int j0 = half * 16, nj = half ? 15 : 16;
            f32x2 wv[16];
#pragma unroll
            for (int j = 0; j < 16; ++j) { if (j < nj) wv[j] = *(const f32x2*)(dww + (j0 + j) * 1024 + c0); else wv[j] = (f32x2){0.f, 0.f}; }
#pragma unroll
            for (int th = 0; th < 2; ++th) {
#pragma unroll
                for (int q = 0; q < 31; ++q) {
                    const int rr = 16 * th + j0 + q;
                    const unsigned v = *(LAS const unsigned*)(lds + rr * 2048 + tid * 4); const f32x2 x = {bflo(v), bfhi(v)};
#pragma unroll
                    for (int i = 0; i < 16; ++i) { const int j = q - i; if (j >= 0 && j < nj) av[16 * th + i] += wv[j] * x; }
                }
                asm volatile("" ::: "memory");
            }
        }
        float a0[32], a1[32];
#pragma unroll
        for (int tt = 0; tt < 32; ++tt) { a0[tt] = av[tt][0]; a1[tt] = av[tt][1]; }
        float st[32];
        { const bool bit = (lane & 32) != 0;
#pragma unroll
          for (int i = 0; i < 32; ++i) { const float s1 = a0[i] + a1[i], s2 = a0[i] * a0[i] + a1[i] * a1[i]; const float keep = bit ? s2 : s1, send = bit ? s1 : s2; st[i] = keep + __shfl_xor(send, 32); } }
#define TR_STEP(N) { const bool bit = (lane & N) != 0; _Pragma("unroll") for (int i = 0; i < N; ++i) { const float keep = bit ? st[i + N] : st[i], send = bit ? st[i] : st[i + N]; st[i] = keep + __shfl_xor(send, N); } }
        TR_STEP(16) TR_STEP(8) TR_STEP(4) TR_STEP(2) TR_STEP(1)
#undef TR_STEP
        red[wid * 64 + lane] = st[0];
        __syncthreads();
        if (tid < 32) {
            float s1 = 0.f, s2 = 0.f;
#pragma unroll
            for (int w = 0; w < 8; ++w) { s1 += red[w * 64 + tid]; s2 += red[w * 64 + 32 + tid]; }
            const float mean = s1 * (1.0f / 1024.0f); const float var = fmaxf(s2 * (1.0f / 1024.0f) - mean * mean, 0.f);
            mr[2 * tid] = mean; mr[2 * tid + 1] = 1.0f / sqrtf(var + 1e-5f);
        }
        __syncthreads();
#pragma unroll
        for (int tt = 0; tt < 32; ++tt) {
            const float mean = mr[2 * tt], rstd = mr[2 * tt + 1];
            float y0 = (a0[tt] - mean) * rstd * gam[0] + bet[0], y1 = (a1[tt] - mean) * rstd * gam[1] + bet[1];
            y0 = y0 * __builtin_amdgcn_rcpf(1.0f + __builtin_amdgcn_exp2f(-1.4426950408889634f * y0));
            y1 = y1 * __builtin_amdgcn_rcpf(1.0f + __builtin_amdgcn_exp2f(-1.4426950408889634f * y1));
            *(LAS unsigned*)(lds + tt * 2048 + tid * 4) = pk2(y0, y1);
        }
        __syncthreads();
        {
            bf16* yb = Y + ((size_t)b * SEQ + t0) * 1024;
#pragma unroll 2
            for (int p = tid; p < 32 * 128; p += NWAVES * 64) { const int rr = p >> 7, pc = p & 127; *(u32x4*)(yb + (size_t)rr * 1024 + pc * 8) = *(LAS const u32x4*)(lds + rr * 2048 + pc * 16); }
        }
        __syncthreads();
    }
    __syncthreads();
}


__device__ __forceinline__ void final_phase(float* H, const float* ssp, const float* gfin, int vcu, int G, int wave, int lane) {
    const int gw = vcu * NWAVES + wave, NGW = G * NWAVES;
    f32x4 gv[4];
#pragma unroll
    for (int j = 0; j < 4; ++j) gv[j] = ((const f32x4*)gfin)[lane + 64 * j];
    for (int m = gw; m < M; m += NGW) {
        const float inv = pg8::row_inv_rms(ssp, m);
        f32x4* xr = (f32x4*)(H + (size_t)m * DM) + lane;
#pragma unroll
        for (int j = 0; j < 4; ++j) { f32x4 v = xr[64 * j]; v = v * inv * gv[j]; xr[64 * j] = v; }
    }
}

#define GAS __attribute__((address_space(1)))
#define XB_TMO      128
#define XB_XCNT(j)  (256  + 64 * (j))
#define XB_XSUB(j)  (1280 + 64 * (j))
#define XB_XGEN(j)  (2304 + 64 * (j))
#define XB_TOP      3328
#define XB_TOPGEN   3392
#define XCD_BAR_WORDS 3456
#define XB_SPIN_CAP (1u << 18)

__device__ __forceinline__ unsigned xb_ld(unsigned* p)              { return __hip_atomic_load(p, __ATOMIC_RELAXED, __HIP_MEMORY_SCOPE_AGENT); }
__device__ __forceinline__ unsigned xb_add(unsigned* p, unsigned v) { return __hip_atomic_fetch_add(p, v, __ATOMIC_RELAXED, __HIP_MEMORY_SCOPE_AGENT); }
__device__ __forceinline__ unsigned xb_xcc_id() { return (unsigned)__builtin_amdgcn_s_getreg((3 << 11) | 20) & 0xFu; }
#define XB_SPIN(cond, bar) do { unsigned _sp = 0; while (cond) { __builtin_amdgcn_s_sleep(1); \
    if ((++_sp & 255u) == 0u) { if (xb_ld(&(bar)[XB_TMO])) break; if (_sp > XB_SPIN_CAP) { atomicAdd(&(bar)[XB_TMO], 1u); break; } } } } while (0)

struct XcdBarrier {
    unsigned* bar; unsigned x;
    volatile LAS unsigned* st;
};

__device__ __forceinline__ XcdBarrier xcd_barrier_post(unsigned* bar, volatile LAS unsigned* st) {
    XcdBarrier b; b.bar = bar; b.x = xb_xcc_id(); b.st = st;
    if (threadIdx.x == 0) (void)xb_add(&bar[XB_XCNT(b.x)], 1u);
    return b;
}
__device__ __forceinline__ void xcd_barrier_complete(unsigned* bar, unsigned x, unsigned& nloc, unsigned& nx) {
    const unsigned G = gridDim.x * gridDim.y * gridDim.z;
    unsigned sum, cnt, mine, sp = 0u;
    for (;;) {
        sum = 0u; cnt = 0u; mine = 0u;
#pragma unroll
        for (unsigned j = 0; j < 16; ++j) { const unsigned c = xb_ld(&bar[XB_XCNT(j)]); sum += c; cnt += (c > 0u) ? 1u : 0u; mine = (j == x) ? c : mine; }
        if (sum == G) break;
        __builtin_amdgcn_s_sleep(1);
        if ((++sp & 255u) == 0u) { if (xb_ld(&bar[XB_TMO])) break; if (sp > XB_SPIN_CAP) { atomicAdd(&bar[XB_TMO], 1u); break; } }
    }
    nloc = mine > 0u ? mine : 1u; nx = cnt > 0u ? cnt : 1u;
}

__device__ __forceinline__ void xcd_barrier(const XcdBarrier& b) {
    asm volatile("s_waitcnt vmcnt(0)" ::: "memory");
    __syncthreads();
    if (threadIdx.x == 0) {
        unsigned* bar = b.bar;
        __builtin_amdgcn_s_waitcnt(0);
        unsigned nloc = b.st[0], nx = b.st[1];
        if (nloc == 0u) { xcd_barrier_complete(bar, b.x, nloc, nx); b.st[0] = nloc; b.st[1] = nx; }
        const unsigned old = xb_add(&bar[XB_XSUB(b.x)], 1u);
        const unsigned gen = old / nloc;
        if (old + 1u == (gen + 1u) * nloc) {
            __builtin_amdgcn_fence(__ATOMIC_RELEASE, "agent");
            asm volatile("s_waitcnt vmcnt(0)" ::: "memory");
            const unsigned og = xb_add(&bar[XB_TOP], 1u);
            const unsigned tg = og / nx;
            if (og + 1u == (tg + 1u) * nx) xb_add(&bar[XB_TOPGEN], 1u);
            else XB_SPIN(xb_ld(&bar[XB_TOPGEN]) == tg, bar);
            __builtin_amdgcn_fence(__ATOMIC_ACQUIRE, "agent");
            xb_add(&bar[XB_XGEN(b.x)], 1u);
            asm volatile("s_waitcnt vmcnt(0)" ::: "memory");
        } else {
            XB_SPIN(xb_ld(&bar[XB_XGEN(b.x)]) == gen, bar);
            __builtin_amdgcn_fence(__ATOMIC_ACQUIRE, "agent");
            asm volatile("s_waitcnt vmcnt(0)" ::: "memory");
        }
    }
    __syncthreads();
}

#ifndef PHASE_MASK
#define PHASE_MASK 0xfff
#endif
#define PH(k) ((PHASE_MASK >> (k)) & 1)
#ifndef PROBE_REPEAT
#define PROBE_REPEAT -1
#endif
#define REP(k) for (int rep_ = 0; rep_ < ((k) == PROBE_REPEAT ? 2 : 1); ++rep_)
__global__ void __launch_bounds__(NWAVES * 64, 2) fwd_megakernel(Args args) {
    extern __shared__ __attribute__((aligned(16))) unsigned char lds_raw[];
    LAS unsigned char* lds = (LAS unsigned char*)lds_raw;
    cg::grid_group grid = cg::this_grid();
    const int tid = threadIdx.x, lane = tid & 63; const int wave = __builtin_amdgcn_readfirstlane(tid >> 6);
    const int G = gridDim.x; const int bx = blockIdx.x; const int vcu = (G % 8 == 0) ? (bx % 8) * (G / 8) + bx / 8 : bx;
    unsigned char* ws = args.ws;
#define WSP(T, off) ((T*)(ws + (off)))
    float* H = args.out;
    unsigned* barw = (unsigned*)(ws + WS_CTL);
    volatile LAS unsigned* bst = (volatile LAS unsigned*)(lds + MISC_OFF);
    if (threadIdx.x < 2) bst[threadIdx.x] = 0u;
    __syncthreads();
    if (args.use_cg) grid.sync();
    const XcdBarrier xbar = xcd_barrier_post(barw, bst);
    REP(0) if (PH(0)) { const int t_ = opaque_tid(); prologue(args, lds, vcu, G, __builtin_amdgcn_readfirstlane(t_ >> 6), t_ & 63); }
    xcd_barrier(xbar);
    REP(1) if (PH(1)) { pg8::Gemm g{WSP(bf16, WS_AB), WSP(bf16, WS_WIN), M, INW, DM}; pg8::StaticOrder S; S.init(M, INW, G, bx); pg8::EpiIn E{WSP(bf16, WS_Z), WSP(float, WS_ROPE)};
      pg8::gemm_phase<pg8::EpiIn, pg8::StaticOrder, true, true>(lds, g, S, E); }
    xcd_barrier(xbar);
    REP(2) if (PH(2)) {
        bf16* Z = WSP(bf16, WS_Z); bf16* CAT = WSP(bf16, WS_CAT);
        pool_phase(Z, CAT, vcu, G, opaque_tid());
        float sa = args.in[9][lane] * args.in[10][lane], sb = args.in[11][lane] * args.in[12][lane];
        sa = wave_sum(sa); sb = wave_sum(sb);
        const float lam = __builtin_amdgcn_exp2f(sa * 1.4426950408889634f) - __builtin_amdgcn_exp2f(sb * 1.4426950408889634f) + 0.2f;
        const bf16* Qp = Z + (size_t)M * 512; const bf16* Kp = Z + (size_t)2 * M * 512; const bf16* Vp = Z + (size_t)3 * M * 512;
        for (int u = vcu; u < 16 * 16; u += G) {
            const int bh = u >> 4, s = u & 15;
#pragma unroll 1
            for (int i = 0; i < 4; ++i) { const int qb = (i == 0) ? s : (i == 1) ? 31 - s : (i == 2) ? 32 + s : 63 - s;
                att::attn_unit(bh >> 2, bh & 3, qb, Qp, Kp, Vp, CAT, args.in[13], lam, lds); }
        }
    }
    xcd_barrier(xbar);
    REP(3) if (PH(3)) { pg8::Gemm g{WSP(bf16, WS_CAT), WSP(bf16, WS_WCAT), M, DM, DM}; pg8::StaticOrder S; S.init(M, DM, G, bx); pg8::EpiRes E{args.in[0], H, WSP(bf16, WS_AB), nullptr, WSP(float, WS_SSP)};
      pg8::gemm_phase<pg8::EpiRes, pg8::StaticOrder, true, true>(lds, g, S, E); }
    xcd_barrier(xbar);
    REP(4) if (PH(4)) { pg8::Gemm g{WSP(bf16, WS_AB), WSP(bf16, WS_WUP), M, DFF, DM}; pg8::StaticOrder S; S.init(M, DFF, G, bx); pg8::EpiUp E{WSP(bf16, WS_HID), WSP(float, WS_SSP)};
      pg8::gemm_phase<pg8::EpiUp, pg8::StaticOrder, true, true>(lds, g, S, E); }
    xcd_barrier(xbar);
    REP(5) if (PH(5)) { pg8::Gemm g{WSP(bf16, WS_HID), WSP(bf16, WS_WDN), M, DM, DFF}; pg8::StaticOrder S; S.init(M, DM, G, bx); pg8::EpiRes E{H, H, WSP(bf16, WS_AB), nullptr, WSP(float, WS_SSP)};
      pg8::gemm_phase<pg8::EpiRes, pg8::StaticOrder, true, true>(lds, g, S, E); }
    xcd_barrier(xbar);
    REP(6) if (PH(6)) { pg8::Gemm g{WSP(bf16, WS_AB), WSP(bf16, WS_PW1), M, INW, DM}; pg8::StaticOrder S; S.init(M, INW, G, bx); pg8::EpiGlu E{WSP(bf16, WS_G), WSP(float, WS_SSP), args.in[16]};
      pg8::gemm_phase<pg8::EpiGlu, pg8::StaticOrder, true, true>(lds, g, S, E); }
    xcd_barrier(xbar);
    REP(7) if (PH(7)) conv_phase(lds, WSP(bf16, WS_G), WSP(bf16, WS_Y), args.in[17], args.in[18], args.in[19], args.in[20], vcu, G);
    xcd_barrier(xbar);
    REP(8) if (PH(8)) { pg8::Gemm g{WSP(bf16, WS_Y), WSP(bf16, WS_PW2), M, DM, DM}; pg8::StaticOrder S; S.init(M, DM, G, bx); pg8::EpiRes E{H, H, WSP(bf16, WS_AB), args.in[22], WSP(float, WS_SSP)};
      pg8::gemm_phase<pg8::EpiRes, pg8::StaticOrder, true, true>(lds, g, S, E); }
    xcd_barrier(xbar);
    REP(9) if (PH(9)) { pg8::Gemm g{WSP(bf16, WS_AB), WSP(bf16, WS_WUP) + (size_t)DFF * DM, M, DFF, DM}; pg8::StaticOrder S; S.init(M, DFF, G, bx); pg8::EpiUp E{WSP(bf16, WS_HID), WSP(float, WS_SSP)};
      pg8::gemm_phase<pg8::EpiUp, pg8::StaticOrder, true, true>(lds, g, S, E); }
    xcd_barrier(xbar);
    REP(10) if (PH(10)) { pg8::Gemm g{WSP(bf16, WS_HID), WSP(bf16, WS_WDN) + (size_t)DM * DFF, M, DM, DFF}; pg8::StaticOrder S; S.init(M, DM, G, bx); pg8::EpiRes E{H, H, nullptr, nullptr, WSP(float, WS_SSP)};
      pg8::gemm_phase<pg8::EpiRes, pg8::StaticOrder, true, true>(lds, g, S, E); }
    xcd_barrier(xbar);
    if (PH(11)) { const int t_ = opaque_tid(); final_phase(H, WSP(float, WS_SSP), args.in[5], vcu, G, __builtin_amdgcn_readfirstlane(t_ >> 6), t_ & 63); }
}

extern "C" void kernel_launch(void* const* d_in, const int* in_sizes, int n_in, void* d_out, int out_size, void* d_ws, size_t ws_size, hipStream_t stream) {
    static int grid = 0;
    if (grid == 0) {
        if (n_in != 23 || in_sizes[0] != M * DM || out_size != M * DM || ws_size < WS_END) { fprintf(stderr, "kernel_launch: unexpected shapes (n_in %d, in0 %d, out %d, ws %zu)\n", n_in, n_in > 0 ? in_sizes[0] : -1, out_size, ws_size); grid = -1; return; }
        int dev = 0, cus = 0, per_cu = 0;
        if (hipGetDevice(&dev) != hipSuccess || hipDeviceGetAttribute(&cus, hipDeviceAttributeMultiprocessorCount, dev) != hipSuccess) { grid = -1; return; }
        if (hipFuncSetAttribute((const void*)fwd_megakernel, hipFuncAttributeMaxDynamicSharedMemorySize, LDS_BYTES) != hipSuccess) { fprintf(stderr, "kernel_launch: hipFuncSetAttribute failed\n"); grid = -1; return; }
        if (hipOccupancyMaxActiveBlocksPerMultiprocessor(&per_cu, (const void*)fwd_megakernel, NWAVES * 64, LDS_BYTES) != hipSuccess || per_cu < 1) { fprintf(stderr, "kernel_launch: occupancy query says %d\n", per_cu); per_cu = 1; }
        (void)hipGetLastError();
        grid = cus * 1;
        fprintf(stderr, "kernel_launch: grid %d (cus %d, occupancy %d)\n", grid, cus, per_cu);
    }
    if (grid < 0) return;
    if (hipMemsetAsync((char*)d_ws + WS_CTL, 0, 16384, stream) != hipSuccess) { fprintf(stderr, "kernel_launch: hipMemsetAsync failed\n"); return; }
    Args a{};
    for (int i = 0; i < 23; ++i) a.in[i] = (const float*)d_in[i];
    a.out = (float*)d_out; a.ws = (unsigned char*)d_ws;
    for (int i = 0; i < 8; ++i) a.invf[i] = (float)std::pow(500000.0, -(double)i / 8.0);
    void* kargs[] = {&a};
    hipError_t e = hipLaunchCooperativeKernel((const void*)fwd_megakernel, dim3(grid), dim3(NWAVES * 64), kargs, LDS_BYTES, stream);
    if (e != hipSuccess) fprintf(stderr, "kernel_launch: cooperative launch failed: %s (grid %d)\n", hipGetErrorString(e), grid);
}
```

```cpp
#include <hip/hip_runtime.h>
#include <hip/hip_cooperative_groups.h>
#include <cstdio>
#include <cstdint>
#include <cmath>
namespace cg = cooperative_groups;

__device__ __forceinline__ int opaque_tid() { int t = threadIdx.x; asm volatile("" : "+v"(t)); return t; }

namespace pg8 {
#define PG8_LAS __attribute__((address_space(3)))
typedef unsigned short bf16_t;
typedef short bf16x8 __attribute__((ext_vector_type(8)));
typedef float f32x4 __attribute__((ext_vector_type(4)));
typedef unsigned u32x4 __attribute__((ext_vector_type(4)));
constexpr int BM = 256, BK = 64, HALF = 128, HTB = HALF * BK * 2  , STAGE_BYTES = 8 * HTB, NXCD = 8, WGM = 8;

__host__ __device__ __forceinline__ int lds_byte(int r, int c) { const int st = (r >> 4) * 2 + (c >> 5), rr = r & 15, cc = c & 31, ob = rr * 64 + cc * 2; return st * 1024 + (ob ^ (((ob >> 9) & 1) << 5)); }
__host__ __device__ __forceinline__ void stage_rc(int b, int& R, int& C) { const int st = b / 1024, sb = b % 1024, swz = sb ^ (((sb >> 9) & 1) << 5); R = (st >> 1) * 16 + swz / 64; C = (st & 1) * 32 + (swz % 64) / 2; }
__host__ __device__ __forceinline__ int perm32(int rho) { const int n = rho >> 4, i = rho & 15; return 8 * (i >> 2) + 4 * n + (i & 3); }

struct Unit { int pm, pn; };
struct Gemm { const bf16_t* A; const bf16_t* Bt; int M, N, K; };

struct StaticOrder {
    int nM, nN, nwg, G, c;
    __host__ __device__ void init(int M, int N, int G_, int c_) { nM = M / BM; nN = N / BM; nwg = nM * nN; G = G_; c = c_; }
    __host__ __device__ bool next(int i, Unit& u) const {
        const long L = (long)i * G + c; if (L >= nwg) return false;
        int wgid = (int)L; { const int q = nwg / NXCD, r = nwg % NXCD, xcd = wgid % NXCD, off = wgid / NXCD; wgid = (xcd < r ? xcd * (q + 1) : r * (q + 1) + (xcd - r) * q) + off; }
        const int nig = WGM * nN, gid = wgid / nig, fm = gid * WGM, gsz = (nM - fm) < WGM ? (nM - fm) : WGM;
        u.pm = fm + ((wgid % nig) % gsz); u.pn = (wgid % nig) / gsz; return true;
    }
    __device__ __forceinline__ void a_ready(const Unit&) const {}
    __device__ __forceinline__ void done(const Unit&) const {}
};

typedef float f32x2v __attribute__((ext_vector_type(2))); typedef __bf16 bf16x2v __attribute__((ext_vector_type(2)));
__device__ __forceinline__ unsigned cvt_pk_bf16(float lo, float hi) { f32x2v v = {lo, hi}; bf16x2v b = __builtin_convertvector(v, bf16x2v); return __builtin_bit_cast(unsigned, b); }
__device__ __forceinline__ u32x4 pack8(const f32x4& v0, const f32x4& v1) { u32x4 w; w.x = cvt_pk_bf16(v0[0], v0[1]); w.y = cvt_pk_bf16(v0[2], v0[3]); w.z = cvt_pk_bf16(v1[0], v1[1]); w.w = cvt_pk_bf16(v1[2], v1[3]); return w; }

constexpr int MROWS = 32768;
constexpr float C2 = 0.125f * 1.4426950408889634f;
constexpr float RMS_EPS = 1e-6f;

__device__ __forceinline__ float row_inv_rms(const float* ssp, int row) {
    const f32x4* p = (const f32x4*)(ssp + (size_t)row * 16);
    const f32x4 a = p[0], b = p[1], c = p[2], d = p[3];
    const float s = ((a[0] + a[1]) + (a[2] + a[3])) + ((b[0] + b[1]) + (b[2] + b[3])) + ((c[0] + c[1]) + (c[2] + c[3])) + ((d[0] + d[1]) + (d[2] + d[3]));
    return 1.0f / sqrtf(s * (1.0f / 1024.0f) + RMS_EPS);
}
__device__ __forceinline__ void row_scales8(const float* ssp, int row0, int fq, float (&sc)[8]) {
#pragma unroll
    for (int k = 0; k < 8; ++k) { const int row = row0 + (k >> 2) * HALF + (k & 3) * 16; const f32x4 p = *(const f32x4*)(ssp + (size_t)row * 16 + 4 * fq); sc[k] = (p[0] + p[1]) + (p[2] + p[3]); }
#pragma unroll
    for (int k = 0; k < 8; ++k) { float s = sc[k]; s += __shfl_xor(s, 16); s += __shfl_xor(s, 32); sc[k] = 1.0f / sqrtf(s * (1.0f / 1024.0f) + RMS_EPS); }
}

struct EpiIn {
    static constexpr bool PERM = true, AFTER_DRAIN = false;
    bf16_t* Z; const float* rope;
    __device__ __forceinline__ void operator()(const f32x4 (&acc)[2][2][4][2], const Unit& u, int wr, int wc, int fr, int fq) const {
        const int sec = u.pn >> 1;
        bf16_t* base = Z + (size_t)sec * MROWS * 512;
        const int cs0 = (u.pn & 1) * 256 + wc * 32 + 8 * fq;
        const int row0 = u.pm * BM + wr * 64 + fr;
        const bool ropew = (sec == 1 || sec == 2) && ((wc & 1) == 0);
        const float sc = (sec == 1) ? C2 : 1.0f;
#pragma unroll
        for (int ai = 0; ai < 2; ++ai) {
            f32x4 c0[4], c1[4], s0[4], s1[4];
#pragma unroll
            for (int m = 0; m < 4; ++m) { c0[m] = (f32x4){1.f, 1.f, 1.f, 1.f}; c1[m] = c0[m]; s0[m] = (f32x4){0.f, 0.f, 0.f, 0.f}; s1[m] = s0[m]; }
            if (ropew) {
#pragma unroll
                for (int m = 0; m < 4; ++m) { const int pos = (row0 + ai * HALF + m * 16) & 8191; const f32x4* cp = (const f32x4*)(rope + (size_t)pos * 8); const f32x4* sp = (const f32x4*)(rope + 65536 + (size_t)pos * 8);
                    c0[m] = cp[0]; c1[m] = cp[1]; s0[m] = sp[0]; s1[m] = sp[1]; }
            }
#pragma unroll
            for (int m = 0; m < 4; ++m) {
                const int row = row0 + ai * HALF + m * 16;
#pragma unroll
                for (int bj = 0; bj < 2; ++bj) {
                    f32x4 v0 = acc[ai][bj][m][0], v1 = acc[ai][bj][m][1];
                    if (ropew) {
                        f32x4 p0, p1;
#pragma unroll
                        for (int e = 0; e < 4; ++e) { p0[e] = __shfl_xor(v0[e], 16); p1[e] = __shfl_xor(v1[e], 16); }
                        if (fq == 0) { v0 = v0 * c0[m] - p0 * s0[m]; v1 = v1 * c1[m] - p1 * s1[m]; }
                        else if (fq == 1) { v0 = v0 * c0[m] + p0 * s0[m]; v1 = v1 * c1[m] + p1 * s1[m]; }
                    }
                    v0 = v0 * sc; v1 = v1 * sc;
                    *(u32x4*)(base + (size_t)row * 512 + cs0 + bj * HALF) = pack8(v0, v1);
                }
            }
            asm volatile("" ::: "memory");
        }
    }
};

template <bool RES_BF16, bool OUT_F32>
struct EpiRes {
    static constexpr bool PERM = true, AFTER_DRAIN = false;
    const float* Rf; const bf16_t* HBin; float* Hf; bf16_t* HBout; const float* bias; float* ssp;
    __device__ __forceinline__ void operator()(const f32x4 (&acc)[2][2][4][2], const Unit& u, int wr, int wc, int fr, int fq) const {
        const int row0 = u.pm * BM + wr * 64 + fr, col0 = u.pn * BM + wc * 32 + 8 * fq;
        f32x4 bv[2][2];
#pragma unroll
        for (int bj = 0; bj < 2; ++bj)
#pragma unroll
            for (int n = 0; n < 2; ++n) bv[bj][n] = bias ? *(const f32x4*)(bias + col0 + bj * HALF + 4 * n) : (f32x4){0.f, 0.f, 0.f, 0.f};
#pragma unroll
        for (int ai = 0; ai < 2; ++ai) {
            f32x4 pre[4][2][2];
#pragma unroll
            for (int m = 0; m < 4; ++m)
#pragma unroll
                for (int bj = 0; bj < 2; ++bj) { const size_t off = (size_t)(row0 + ai * HALF + m * 16) * 1024 + col0 + bj * HALF;
                    if (RES_BF16) { const u32x4 w = *(const u32x4*)(HBin + off);
                        pre[m][bj][0] = (f32x4){__uint_as_float(w.x << 16), __uint_as_float(w.x & 0xffff0000u), __uint_as_float(w.y << 16), __uint_as_float(w.y & 0xffff0000u)};
                        pre[m][bj][1] = (f32x4){__uint_as_float(w.z << 16), __uint_as_float(w.z & 0xffff0000u), __uint_as_float(w.w << 16), __uint_as_float(w.w & 0xffff0000u)}; }
                    else { pre[m][bj][0] = *(const f32x4*)(Rf + off); pre[m][bj][1] = *(const f32x4*)(Rf + off + 4); } }
#pragma unroll
            for (int m = 0; m < 4; ++m) {
                const int row = row0 + ai * HALF + m * 16; float ss = 0.f;
#pragma unroll
                for (int bj = 0; bj < 2; ++bj) {
                    const size_t off = (size_t)row * 1024 + col0 + bj * HALF;
                    const f32x4 v0 = acc[ai][bj][m][0] + bv[bj][0] + pre[m][bj][0], v1 = acc[ai][bj][m][1] + bv[bj][1] + pre[m][bj][1];
                    if (OUT_F32) { *(f32x4*)(Hf + off) = v0; *(f32x4*)(Hf + off + 4) = v1; }
                    else *(u32x4*)(HBout + off) = pack8(v0, v1);
                    ss += (v0[0] * v0[0] + v0[1] * v0[1]) + (v0[2] * v0[2] + v0[3] * v0[3]) + (v1[0] * v1[0] + v1[1] * v1[1]) + (v1[2] * v1[2] + v1[3] * v1[3]);
                }
                ss += __shfl_xor(ss, 16); ss += __shfl_xor(ss, 32);
                if (fq == 0) ssp[(size_t)row * 16 + u.pn * 4 + wc] = ss;
            }
            asm volatile("" ::: "memory");
        }
    }
};

struct EpiUp {
    static constexpr bool PERM = true, AFTER_DRAIN = false;
    bf16_t* O; const float* ssp;
    __device__ __forceinline__ void operator()(const f32x4 (&acc)[2][2][4][2], const Unit& u, int wr, int wc, int fr, int fq) const {
        const int row0 = u.pm * BM + wr * 64 + fr, col0 = u.pn * BM + wc * 32 + 8 * fq;
        float sc[8]; row_scales8(ssp, row0, fq, sc);
#pragma unroll
        for (int ai = 0; ai < 2; ++ai)
#pragma unroll
            for (int m = 0; m < 4; ++m) {
                const int row = row0 + ai * HALF + m * 16; const float s = sc[ai * 4 + m];
#pragma unroll
                for (int bj = 0; bj < 2; ++bj) {
                    f32x4 v0 = acc[ai][bj][m][0] * s, v1 = acc[ai][bj][m][1] * s;
#pragma unroll
                    for (int e = 0; e < 4; ++e) { const float a = fmaxf(v0[e], 0.f), b = fmaxf(v1[e], 0.f); v0[e] = a * a; v1[e] = b * b; }
                    *(u32x4*)(O + (size_t)row * 4096 + col0 + bj * HALF) = pack8(v0, v1);
                }
            }
    }
};

struct EpiGlu {
    static constexpr bool PERM = true, AFTER_DRAIN = false;
    bf16_t* O; const float* ssp; const float* bias;
    __device__ __forceinline__ void operator()(const f32x4 (&acc)[2][2][4][2], const Unit& u, int wr, int wc, int fr, int fq) const {
        const int row0 = u.pm * BM + wr * 64 + fr, col0 = u.pn * HALF + wc * 32 + 8 * fq;
        const f32x4 bv0 = *(const f32x4*)(bias + col0), bv1 = *(const f32x4*)(bias + col0 + 4), bg0 = *(const f32x4*)(bias + 1024 + col0), bg1 = *(const f32x4*)(bias + 1024 + col0 + 4);
        float sc[8]; row_scales8(ssp, row0, fq, sc);
#pragma unroll
        for (int ai = 0; ai < 2; ++ai)
#pragma unroll
            for (int m = 0; m < 4; ++m) {
                const int row = row0 + ai * HALF + m * 16; const float s = sc[ai * 4 + m];
                f32x4 a0 = acc[ai][0][m][0] * s + bv0, a1 = acc[ai][0][m][1] * s + bv1;
                const f32x4 g0 = acc[ai][1][m][0] * s + bg0, g1 = acc[ai][1][m][1] * s + bg1;
#pragma unroll
                for (int e = 0; e < 4; ++e) {
                    a0[e] = a0[e] * __builtin_amdgcn_rcpf(1.0f + __builtin_amdgcn_exp2f(-1.4426950408889634f * g0[e]));
                    a1[e] = a1[e] * __builtin_amdgcn_rcpf(1.0f + __builtin_amdgcn_exp2f(-1.4426950408889634f * g1[e]));
                }
                *(u32x4*)(O + (size_t)row * 1024 + col0) = pack8(a0, a1);
            }
    }
};

template <class Epi, class Sched, bool ALIGN_EPI = false, bool SP2 = false>
__device__ __forceinline__ void gemm_phase(PG8_LAS unsigned char* lds, const Gemm g, const Sched& S, const Epi& E) {
    const int tid = opaque_tid(), wid = __builtin_amdgcn_readfirstlane(tid >> 6), lane = tid & 63, wr = wid >> 2, wc = wid & 3, fr = lane & 15, fq = lane >> 4;
    const int K = g.K, nt = K / BK;
    unsigned voffA[2], voffB[2];
#pragma unroll
    for (int i = 0; i < 2; ++i) { int R, C; stage_rc(tid * 16 + i * 8192, R, C); const int Rb = Epi::PERM ? ((R & ~31) + perm32(R & 31)) : R;
        voffA[i] = (unsigned)(R * K + C) * 2u; voffB[i] = (unsigned)(Rb * K + C) * 2u; }
    const size_t kstep = (size_t)(BK * 2);
    const size_t hstep = (size_t)HALF * K * 2;
    const size_t tstep = 2 * hstep;
    const unsigned ldsw = (unsigned)wid * 1024u;
    const int aoff = lds_byte(wr * 64 + fr, fq * 8), boff = lds_byte(wc * 32 + fr, fq * 8);
#define PG8_SA(b, h) (((b) * 2 + (h)) * HTB)
#define PG8_SB(b, h) ((4 + (b) * 2 + (h)) * HTB)
#define PG8_STAGE(bufoff, gbase, voff) do { _Pragma("unroll") for (int _i = 0; _i < 2; ++_i) \
        __builtin_amdgcn_global_load_lds((const unsigned*)((const char*)(gbase) + (voff)[_i]), (PG8_LAS unsigned*)(lds + (bufoff) + ldsw + _i * 8192), 16, 0, 0); } while (0)
#define PG8_LDA(dst, b, h) do { _Pragma("unroll") for (int m = 0; m < 4; ++m) _Pragma("unroll") for (int k = 0; k < 2; ++k) dst[m][k] = *(const PG8_LAS bf16x8*)(lds + PG8_SA(b, h) + aoff + m * 2048 + k * 1024); } while (0)
#define PG8_LDB(dst, b, h) do { _Pragma("unroll") for (int n = 0; n < 2; ++n) _Pragma("unroll") for (int k = 0; k < 2; ++k) dst[n][k] = *(const PG8_LAS bf16x8*)(lds + PG8_SB(b, h) + boff + n * 2048 + k * 1024); } while (0)
#define PG8_MMA(ai, bj, At, Bt) do { __builtin_amdgcn_s_setprio(1); _Pragma("unroll") for (int m = 0; m < 4; ++m) _Pragma("unroll") for (int n = 0; n < 2; ++n) _Pragma("unroll") for (int k = 0; k < 2; ++k) \
        acc[ai][bj][m][n] = __builtin_amdgcn_mfma_f32_16x16x32_bf16(Bt[n][k], At[m][k], acc[ai][bj][m][n], 0, 0, 0); __builtin_amdgcn_s_setprio(0); } while (0)
#define PG8_WAIT_V(n) asm volatile("s_waitcnt vmcnt(" #n ")" ::: "memory")
#define PG8_WAIT_L(n) asm volatile("s_waitcnt lgkmcnt(" #n ")" ::: "memory")
#define PG8_BAR __builtin_amdgcn_s_barrier()
#define PG8_SCHED __builtin_amdgcn_sched_barrier(0)
    Unit cur, nxt; int ui = 0;
    if (!S.next(0, cur)) return;
    f32x4 acc[2][2][4][2];
#pragma unroll
    for (int a = 0; a < 2; ++a)
#pragma unroll
        for (int b = 0; b < 2; ++b)
#pragma unroll
            for (int m = 0; m < 4; ++m)
#pragma unroll
                for (int n = 0; n < 2; ++n) acc[a][b][m][n] = (f32x4){0.f, 0.f, 0.f, 0.f};
    bf16x8 At[4][2], B0[2][2], B1[2][2];
    const char* cA = (const char*)g.A + (size_t)cur.pm * tstep; const char* cB = (const char*)g.Bt + (size_t)cur.pn * tstep;
    S.a_ready(cur);
    if constexpr (SP2) {
        PG8_STAGE(PG8_SB(0, 0), cB, voffB); PG8_STAGE(PG8_SB(0, 1), cB + hstep, voffB); PG8_STAGE(PG8_SA(0, 0), cA, voffA); PG8_STAGE(PG8_SA(0, 1), cA + hstep, voffA);
        if (wr == 1) PG8_BAR;
        PG8_WAIT_V(2); PG8_BAR;
        PG8_STAGE(PG8_SB(1, 0), cB + kstep, voffB); PG8_STAGE(PG8_SA(1, 0), cA + kstep, voffA); PG8_STAGE(PG8_SB(1, 1), cB + hstep + kstep, voffB);
        PG8_WAIT_V(6); PG8_BAR;
    } else {
        PG8_STAGE(PG8_SB(0, 0), cB, voffB); PG8_STAGE(PG8_SA(0, 0), cA, voffA); PG8_STAGE(PG8_SB(0, 1), cB + hstep, voffB); PG8_STAGE(PG8_SA(0, 1), cA + hstep, voffA);
        if (wr == 1) PG8_BAR;
        PG8_WAIT_V(4); PG8_BAR;
        PG8_STAGE(PG8_SB(1, 0), cB + kstep, voffB); PG8_STAGE(PG8_SA(1, 0), cA + kstep, voffA); PG8_STAGE(PG8_SB(1, 1), cB + hstep + kstep, voffB);
        PG8_WAIT_V(6); PG8_BAR;
    }
    for (;;) {
        const bool has_next = S.next(ui + 1, nxt);
        const char* nA = has_next ? (const char*)g.A + (size_t)nxt.pm * tstep : cA; const char* nB = has_next ? (const char*)g.Bt + (size_t)nxt.pn * tstep : cB;
        for (int t = 0; t < nt; t += 2) {
            const bool last = (t == nt - 2);
            const char* a1 = cA + (size_t)(t + 1) * kstep;
            const char* a2 = last ? nA : cA + (size_t)(t + 2) * kstep; const char* b2 = last ? nB : cB + (size_t)(t + 2) * kstep;
            const char* a3 = a2 + kstep; const char* b3 = b2 + kstep;
            if (last && has_next) S.a_ready(nxt);
            if constexpr (SP2) {
            PG8_LDB(B0, 0, 0); PG8_LDB(B1, 0, 1); PG8_SCHED; PG8_LDA(At, 0, 0); PG8_STAGE(PG8_SA(1, 1), a1 + hstep, voffA);
            PG8_WAIT_V(8); PG8_WAIT_L(0); PG8_BAR; PG8_MMA(0, 0, At, B0); PG8_MMA(0, 1, At, B1); PG8_BAR; PG8_SCHED;
            PG8_LDA(At, 0, 1); PG8_STAGE(PG8_SB(0, 0), b2, voffB); PG8_STAGE(PG8_SB(0, 1), b2 + hstep, voffB); PG8_STAGE(PG8_SA(0, 0), a2, voffA);
            PG8_WAIT_V(8); PG8_WAIT_L(0); PG8_BAR; PG8_MMA(1, 0, At, B0); PG8_MMA(1, 1, At, B1); PG8_BAR; PG8_SCHED;
            PG8_LDB(B0, 1, 0); PG8_LDB(B1, 1, 1); PG8_SCHED; PG8_LDA(At, 1, 0); PG8_STAGE(PG8_SA(0, 1), a2 + hstep, voffA);
            PG8_WAIT_V(8); PG8_WAIT_L(0); PG8_BAR; PG8_MMA(0, 0, At, B0); PG8_MMA(0, 1, At, B1); PG8_BAR; PG8_SCHED;
            PG8_LDA(At, 1, 1); PG8_STAGE(PG8_SB(1, 0), b3, voffB); PG8_STAGE(PG8_SB(1, 1), b3 + hstep, voffB); PG8_STAGE(PG8_SA(1, 0), a3, voffA);
            PG8_WAIT_V(8); PG8_WAIT_L(0); PG8_BAR; PG8_MMA(1, 0, At, B0); PG8_MMA(1, 1, At, B1); PG8_BAR; PG8_SCHED;
            } else {
            PG8_LDB(B0, 0, 0); PG8_SCHED; PG8_LDA(At, 0, 0); PG8_STAGE(PG8_SA(1, 1), a1 + hstep, voffA);
            PG8_WAIT_L(8); PG8_BAR; PG8_WAIT_L(0); PG8_MMA(0, 0, At, B0); PG8_BAR; PG8_SCHED;
            PG8_LDB(B1, 0, 1); PG8_STAGE(PG8_SB(0, 0), b2, voffB);
            PG8_BAR; PG8_WAIT_L(0); PG8_MMA(0, 1, At, B1); PG8_BAR;
            PG8_LDA(At, 0, 1); PG8_STAGE(PG8_SA(0, 0), a2, voffA);
            PG8_BAR; PG8_WAIT_L(0); PG8_MMA(1, 0, At, B0); PG8_BAR; PG8_SCHED;
            PG8_STAGE(PG8_SB(0, 1), b2 + hstep, voffB);
            PG8_WAIT_V(6); PG8_BAR; PG8_MMA(1, 1, At, B1); PG8_BAR;
            PG8_LDB(B0, 1, 0); PG8_SCHED; PG8_LDA(At, 1, 0); PG8_STAGE(PG8_SA(0, 1), a2 + hstep, voffA);
            PG8_WAIT_L(8); PG8_BAR; PG8_WAIT_L(0); PG8_MMA(0, 0, At, B0); PG8_BAR; PG8_SCHED;
            PG8_LDB(B1, 1, 1); PG8_STAGE(PG8_SB(1, 0), b3, voffB);
            PG8_BAR; PG8_WAIT_L(0); PG8_MMA(0, 1, At, B1); PG8_BAR;
            PG8_LDA(At, 1, 1); PG8_STAGE(PG8_SA(1, 0), a3, voffA);
            PG8_BAR; PG8_WAIT_L(0); PG8_MMA(1, 0, At, B0); PG8_BAR; PG8_SCHED;
            PG8_STAGE(PG8_SB(1, 1), b3 + hstep, voffB);
            PG8_WAIT_V(6); PG8_BAR; PG8_MMA(1, 1, At, B1); PG8_BAR;
            }
        }
        if constexpr (ALIGN_EPI) { if (wr == 0) PG8_BAR; }
        if constexpr (!Epi::AFTER_DRAIN) { E(acc, cur, wr, wc, fr, fq); S.done(cur); }
        if (!has_next) break;
#pragma unroll
        for (int a = 0; a < 2; ++a)
#pragma unroll
            for (int b = 0; b < 2; ++b)
#pragma unroll
                for (int m = 0; m < 4; ++m)
#pragma unroll
                    for (int n = 0; n < 2; ++n) acc[a][b][m][n] = (f32x4){0.f, 0.f, 0.f, 0.f};
        cur = nxt; cA = nA; cB = nB; ++ui;
        if constexpr (ALIGN_EPI) { if (wr == 1) PG8_BAR; }
    }
    PG8_WAIT_V(0);
    if constexpr (!ALIGN_EPI) { if (wr == 0) PG8_BAR; }
    PG8_BAR;
    if constexpr (Epi::AFTER_DRAIN) { E.fused(acc, cur, wr, wc, fr, fq, lds, wid, lane); S.done(cur); }
#undef PG8_SA
#undef PG8_SB
#undef PG8_STAGE
#undef PG8_LDA
#undef PG8_LDB
#undef PG8_MMA
#undef PG8_WAIT_V
#undef PG8_WAIT_L
#undef PG8_BAR
#undef PG8_SCHED
}
}

#define LAS __attribute__((address_space(3)))
typedef unsigned short bf16;
typedef unsigned u32x4 __attribute__((ext_vector_type(4)));
typedef unsigned u32x2 __attribute__((ext_vector_type(2)));
typedef float f32x4 __attribute__((ext_vector_type(4)));
typedef float f32x2 __attribute__((ext_vector_type(2)));
typedef float f32x16 __attribute__((ext_vector_type(16)));
typedef short bf16x8 __attribute__((ext_vector_type(8)));
typedef short s16x4 __attribute__((ext_vector_type(4)));
#define LDS_WAIT() asm volatile("s_waitcnt lgkmcnt(0)" ::: "memory")

constexpr int NWAVES = 8;
constexpr int BATCH = 4, SEQ = 8192, DM = 1024, M = BATCH * SEQ, DFF = 4096, INW = 2048;
constexpr int LDS_BYTES = 147456, MISC_OFF = 147200;
constexpr size_t MiB = 1u << 20;
constexpr size_t WS_CTL = 0;
constexpr size_t WS_WIN = 1 * MiB;
constexpr size_t WS_WCAT = 5 * MiB;
constexpr size_t WS_WUP = 7 * MiB;
constexpr size_t WS_WDN = 23 * MiB;
constexpr size_t WS_PW1 = 39 * MiB;
constexpr size_t WS_PW2 = 43 * MiB;
constexpr size_t WS_ROPE = 45 * MiB;
constexpr size_t WS_SSP = 46 * MiB;
constexpr size_t WS_AB = 48 * MiB;
constexpr size_t WS_BIG = 112 * MiB;
constexpr size_t WS_Z = WS_BIG, WS_CAT = WS_BIG + 128 * MiB, WS_HID = WS_BIG, WS_G = WS_BIG, WS_Y = WS_BIG + 64 * MiB;
constexpr size_t WS_END = WS_BIG + 256 * MiB;

__device__ __forceinline__ unsigned pk2(float lo, float hi) { return pg8::cvt_pk_bf16(lo, hi); }
__device__ __forceinline__ float bflo(unsigned v) { return __uint_as_float(v << 16); }
__device__ __forceinline__ float bfhi(unsigned v) { return __uint_as_float(v & 0xffff0000u); }
__device__ __forceinline__ float wave_sum(float v) {
#pragma unroll
    for (int o = 1; o < 64; o <<= 1) v += __shfl_xor(v, o);
    return v;
}

__device__ __forceinline__ void tr_item(const float* W, int ldw, int k0, int n0, const float* gain, bf16* WT, int ldt, int drow0, LAS float* scr, int lane) {
#pragma unroll 8
    for (int i = 0; i < 32; ++i) { const int kk = 2 * i + (lane >> 5); const float g = gain ? gain[k0 + kk] : 1.0f; scr[kk * 33 + (lane & 31)] = W[(size_t)(k0 + kk) * ldw + n0 + (lane & 31)] * g; }
    LDS_WAIT();
    const int c = lane & 7;
#pragma unroll
    for (int j = 0; j < 4; ++j) { const int n = (lane >> 3) + 8 * j; const LAS float* s = scr + (8 * c) * 33 + n;
        u32x4 o; o.x = pk2(s[0 * 33], s[1 * 33]); o.y = pk2(s[2 * 33], s[3 * 33]); o.z = pk2(s[4 * 33], s[5 * 33]); o.w = pk2(s[6 * 33], s[7 * 33]);
        *(u32x4*)(WT + (size_t)(drow0 + n) * ldt + k0 + 8 * c) = o; }
    LDS_WAIT();
}
__device__ __forceinline__ void tr_matrix_item(const float* W, int K, int N, int kbase, const float* gain, bf16* WT, int ldt, int item, bool glu, LAS float* scr, int lane) {
    const int nblk = N / 32, kb = item / nblk, nb = item % nblk; const int k0 = kbase + 64 * kb, n0 = 32 * nb;
    int drow0 = n0;
    if (glu) { const int half = n0 >= 1024 ? 1 : 0, j = n0 - half * 1024; drow0 = 256 * (j >> 7) + 128 * half + (j & 127); }
    tr_item(W, N, k0, n0, gain, WT, ldt, drow0, scr, lane);
}

struct Args {
    const float* in[23]; float* out; unsigned char* ws; float invf[8]; int use_cg; int pad;
};

__device__ __forceinline__ void prologue(const Args& a, LAS unsigned char* lds, int vcu, int G, int wave, int lane) {
    unsigned char* ws = a.ws;
    LAS float* scr = (LAS float*)(lds + wave * 16384);
    const int gw = vcu * NWAVES + wave, NGW = G * NWAVES;
    const float* x = a.in[0]; const float* mix_norm = a.in[1]; const float* mlp_norm = a.in[2]; const float* w_up = a.in[3]; const float* w_down = a.in[4];
    const float* w_in = a.in[6]; const float* pool_w = a.in[7]; const float* pool_scale = a.in[8]; const float* w_out = a.in[14];
    const float* pw1 = a.in[15]; const float* pw2 = a.in[21];
    bf16* WIN = (bf16*)(ws + WS_WIN); bf16* WCAT = (bf16*)(ws + WS_WCAT); bf16* WUP = (bf16*)(ws + WS_WUP); bf16* WDN = (bf16*)(ws + WS_WDN);
    bf16* PW1 = (bf16*)(ws + WS_PW1); bf16* PW2 = (bf16*)(ws + WS_PW2);
    constexpr int I_IN = 16 * 64, I_OUT = 8 * 32, I_UP = 16 * 128, I_DN = 64 * 32, I_PW1 = 16 * 64, I_PW2 = 16 * 32;
    constexpr int NITEMS = I_IN + I_OUT + 2 * I_UP + 2 * I_DN + I_PW1 + I_PW2;
    for (int it = gw; it < NITEMS; it += NGW) {
        int r = it;
        if (r < I_IN) { tr_matrix_item(w_in, 1024, 2048, 0, nullptr, WIN, 1024, r, false, scr, lane); continue; } r -= I_IN;
        if (r < I_OUT) { tr_matrix_item(w_out, 512, 1024, 512, nullptr, WCAT, 1024, r, false, scr, lane); continue; } r -= I_OUT;
        if (r < I_UP) { tr_matrix_item(w_up, 1024, 4096, 0, mlp_norm, WUP, 1024, r, false, scr, lane); continue; } r -= I_UP;
        if (r < I_UP) { tr_matrix_item(w_up + (size_t)1024 * 4096, 1024, 4096, 0, mlp_norm + 1024, WUP + (size_t)4096 * 1024, 1024, r, false, scr, lane); continue; } r -= I_UP;
        if (r < I_DN) { tr_matrix_item(w_down, 4096, 1024, 0, nullptr, WDN, 4096, r, false, scr, lane); continue; } r -= I_DN;
        if (r < I_DN) { tr_matrix_item(w_down + (size_t)4096 * 1024, 4096, 1024, 0, nullptr, WDN + (size_t)1024 * 4096, 4096, r, false, scr, lane); continue; } r -= I_DN;
        if (r < I_PW1) { tr_matrix_item(pw1, 1024, 2048, 0, mix_norm + 1024, PW1, 1024, r, true, scr, lane); continue; } r -= I_PW1;
        tr_matrix_item(pw2, 1024, 1024, 0, nullptr, PW2, 1024, r, false, scr, lane);
    }
    for (int it = gw; it < 16 * 64; it += NGW) {
        const int nb = it & 15, kb = it >> 4; const int n = nb * 64 + lane, k0 = kb * 8, g = k0 >> 7;
        float acc8[8];
#pragma unroll
        for (int i = 0; i < 8; ++i) acc8[i] = 0.f;
        for (int d = 0; d < 128; ++d) {
            const float wv = w_out[(size_t)(g * 128 + d) * 1024 + n] * pool_scale[g * 128 + d];
#pragma unroll
            for (int i = 0; i < 8; ++i) acc8[i] += pool_w[(size_t)(k0 + i) * 128 + d] * wv;
        }
        u32x4 o; o.x = pk2(acc8[0], acc8[1]); o.y = pk2(acc8[2], acc8[3]); o.z = pk2(acc8[4], acc8[5]); o.w = pk2(acc8[6], acc8[7]);
        *(u32x4*)(WCAT + (size_t)n * 1024 + k0) = o;
    }
    {
        float* rope = (float*)(ws + WS_ROPE);
        const int gt = (vcu * NWAVES + wave) * 64 + lane, NGT = NGW * 64;
        for (int idx = gt; idx < 8192 * 8; idx += NGT) {
            const int pos = idx >> 3, i = idx & 7;
            const float angf = (float)pos * a.invf[i];
            const double ang = (double)angf;
            const double n = __builtin_rint(ang * 0.15915494309189535);
            const double y = ang - n * 6.283185307179586476925;
            const double y2 = y * y;
            double sp = 1.0, cp = 1.0;
#pragma unroll
            for (int k = 13; k >= 1; --k) { sp = 1.0 - sp * y2 / (double)((2 * k) * (2 * k + 1)); cp = 1.0 - cp * y2 / (double)((2 * k - 1) * (2 * k)); }
            rope[idx] = (float)cp; rope[65536 + idx] = (float)(y * sp);
        }
    }
    {
        bf16* XN = (bf16*)(ws + WS_AB);
        f32x4 gv[4];
#pragma unroll
        for (int j = 0; j < 4; ++j) gv[j] = ((const f32x4*)mix_norm)[lane + 64 * j];
        for (int m = gw; m < M; m += NGW) {
            const f32x4* xr = (const f32x4*)(x + (size_t)m * DM) + lane;
            f32x4 v[4]; float s = 0.f;
#pragma unroll
            for (int j = 0; j < 4; ++j) { v[j] = xr[64 * j]; s += (v[j][0] * v[j][0] + v[j][1] * v[j][1]) + (v[j][2] * v[j][2] + v[j][3] * v[j][3]); }
            const float inv = 1.0f / sqrtf(wave_sum(s) * (1.0f / DM) + 1e-6f);
            u32x2* o8 = (u32x2*)(XN + (size_t)m * DM) + lane;
#pragma unroll
            for (int j = 0; j < 4; ++j) { u32x2 o; o.x = pk2(v[j][0] * inv * gv[j][0], v[j][1] * inv * gv[j][1]); o.y = pk2(v[j][2] * inv * gv[j][2], v[j][3] * inv * gv[j][3]); o8[64 * j] = o; }
        }
    }
}

template <int W> __device__ __forceinline__ void pool_item(const bf16* U, bf16* CAT, int row, int c8) {
    const int t = row & (SEQ - 1);
    u32x4 v[W];
#pragma unroll
    for (int j = 0; j < W; ++j) { const int rj = (j <= t) ? row - j : row; v[j] = *(const u32x4*)(U + (size_t)rj * 512 + c8 * 8); }
    float s[8];
#pragma unroll
    for (int e = 0; e < 8; ++e) s[e] = 0.f;
#pragma unroll
    for (int j = 0; j < W; ++j) { if (j <= t) { s[0] += bflo(v[j].x); s[1] += bfhi(v[j].x); s[2] += bflo(v[j].y); s[3] += bfhi(v[j].y); s[4] += bflo(v[j].z); s[5] += bfhi(v[j].z); s[6] += bflo(v[j].w); s[7] += bfhi(v[j].w); } }
    const float ic = 1.0f / (float)((t + 1 < W) ? (t + 1) : W);
    u32x4 o; o.x = pk2(s[0] * ic - bflo(v[0].x), s[1] * ic - bfhi(v[0].x)); o.y = pk2(s[2] * ic - bflo(v[0].y), s[3] * ic - bfhi(v[0].y));
    o.z = pk2(s[4] * ic - bflo(v[0].z), s[5] * ic - bfhi(v[0].z)); o.w = pk2(s[6] * ic - bflo(v[0].w), s[7] * ic - bfhi(v[0].w));
    *(u32x4*)(CAT + (size_t)row * 1024 + c8 * 8) = o;
}
__device__ __forceinline__ void pool_phase(const bf16* U, bf16* CAT, int vcu, int G, int tid) {
    const int gt = vcu * (NWAVES * 64) + tid, NGT = G * NWAVES * 64;
    for (int it = gt; it < M * 64; it += NGT) {
        const int row = it >> 6, c8 = it & 63; const int g = c8 >> 4;
        if (g == 0) pool_item<2>(U, CAT, row, c8); else if (g == 1) pool_item<4>(U, CAT, row, c8); else if (g == 2) pool_item<8>(U, CAT, row, c8); else pool_item<16>(U, CAT, row, c8);
    }
}

namespace att {
constexpr int KBUF = 0, VBUF = 49152, XOFF = 0, WSF = 98304, SLOT = 16384;
__device__ __forceinline__ int crow(int r, int hi) { return (r & 3) + 8 * (r >> 2) + 4 * hi; }
__device__ __forceinline__ void glds16(const void* gsrc, unsigned lds_dst) { unsigned keep;
    asm volatile("s_mov_b32 %0, m0\n\ts_mov_b32 m0, %2\n\ts_nop 0\n\tglobal_load_lds_dwordx4 %1, off\n\ts_mov_b32 m0, %0" : "=&s"(keep) : "v"(gsrc), "s"(lds_dst) : "memory"); }
typedef short v4i16_t __attribute__((ext_vector_type(4)));
__device__ __forceinline__ s16x4 vtr(LAS const unsigned char* p) { return __builtin_bit_cast(s16x4, __builtin_amdgcn_ds_read_tr16_b64_v4i16((LAS v4i16_t*)p)); }
#define MX3(a, b, c) __builtin_fmaxf(__builtin_fmaxf((a), (b)), (c))
#define MFMA32(a, b, c) __builtin_amdgcn_mfma_f32_32x32x16_bf16(a, b, c, 0, 0, 0)
#define SBAR() __builtin_amdgcn_sched_barrier(0)
#define PIN(x) asm volatile("" : "+v"(x))
constexpr float THR = 8.0f;

__device__ __forceinline__ bf16x8 vfrag(LAS const unsigned char* vp, int i) {
    const int off = (i & 3) * 4096 + (i >> 2) * 1024;
    const s16x4 lo = vtr(vp + off), hh = vtr(vp + off + 512);
    return (bf16x8){lo[0], lo[1], lo[2], lo[3], hh[0], hh[1], hh[2], hh[3]};
}
__device__ __forceinline__ bf16x8 kfrag(LAS const unsigned char* kp, int j) {
    return *(LAS const bf16x8*)(kp + (j >> 1) * 2048 + (j & 1) * 512);
}
#define SEL32(A, B, e) ((e) < 16 ? A[(e) & 15] : B[(e) & 15])

template <bool DO_PV, bool DO_QK, bool BAND>
__device__ __forceinline__ void step(f32x16& S0, f32x16& S1, f32x16& T0, f32x16& T1, f32x16 (&o)[4], u32x4 (&pw)[4], const bf16x8 (&qr)[4],
                                     float& mref, float& l, float& alpha, bool& resc, LAS const unsigned char* kp, LAS const unsigned char* vp, int jb, int qrel, int hi,
                                     const bf16* ks0, const bf16* ks1, const bf16* vs0, const bf16* vs1, unsigned kd0, unsigned kd1, unsigned vd0, unsigned vd1) {
    bf16x8 vf[16]; bf16x8 kf[8];
    if (DO_PV) { vf[0] = vfrag(vp, 0); vf[1] = vfrag(vp, 1); }
    if (BAND) {
        const int kb = 64 * jb + 4 * hi;
#pragma unroll
        for (int r = 0; r < 16; ++r) { const int kv = kb + (r & 3) + 8 * (r >> 2); if (kv > qrel) S0[r] = -INFINITY; if (kv + 32 > qrel) S1[r] = -INFINITY; }
    }
    SBAR();
    float ma = 0.f, mb = 0.f, rm = 0.f;
#pragma unroll
    for (int i = 0; i < 16; ++i) {
        if (DO_PV) { if (i + 2 < 16) vf[i + 2] = vfrag(vp, i + 2); o[i & 3] = MFMA32(__builtin_bit_cast(bf16x8, pw[i >> 2]), vf[i], o[i & 3]); }
        if (i == 0) { ma = MX3(S0[0], S0[1], S1[0]); mb = MX3(S0[2], S0[3], S1[1]); ma = MX3(ma, S1[2], S1[3]);
                      ma = MX3(ma, S0[4], S0[5]); mb = MX3(mb, S0[6], S0[7]); PIN(ma); PIN(mb); }
        else if (i == 1) { ma = MX3(ma, S1[4], S1[5]); mb = MX3(mb, S1[6], S1[7]); ma = MX3(ma, S0[8], S0[9]); mb = MX3(mb, S0[10], S0[11]); ma = MX3(ma, S1[8], S1[9]); PIN(ma); PIN(mb); }
        else if (i == 2) { mb = MX3(mb, S1[10], S1[11]); ma = MX3(ma, S0[12], S0[13]); mb = MX3(mb, S0[14], S0[15]); ma = MX3(ma, S1[12], S1[13]); mb = MX3(mb, S1[14], S1[15]);
                           rm = __builtin_fmaxf(ma, mb); PIN(rm); }
        else if (i == 3) {
            auto rr = __builtin_amdgcn_permlane32_swap(__float_as_uint(rm), __float_as_uint(rm), false, false);
            rm = __builtin_fmaxf(__uint_as_float(rr[0]), __uint_as_float(rr[1]));
            const bool grow = rm > mref + THR; const float mnew = grow ? rm : mref;
            alpha = __builtin_amdgcn_exp2f(mref - mnew); l *= alpha; mref = mnew; resc = __any(grow);
            PIN(mref); PIN(l);
        }
        if (i == 4) glds16(ks0, kd0); else if (i == 7) glds16(ks1, kd1); else if (i == 10) glds16(vs0, vd0); else if (i == 13) glds16(vs1, vd1);
        if (i >= 3) {
            const int e0 = ((i - 3) * 32) / 13, e1 = ((i - 2) * 32) / 13;
#pragma unroll
            for (int e = e0; e < e1; ++e) { if (e < 16) S0[e] = __builtin_amdgcn_exp2f(S0[e] - mref); else S1[e - 16] = __builtin_amdgcn_exp2f(S1[e - 16] - mref); }
            PIN(S0); PIN(S1);
        }
        SBAR();
    }
    if (DO_QK) { kf[0] = kfrag(kp, 0); kf[1] = kfrag(kp, 1); T0 = f32x16{}; T1 = f32x16{}; }
    float sacc = 0.f;
#pragma unroll
    for (int j = 0; j < 8; ++j) {
        if (DO_QK) { if (j + 2 < 8) kf[j + 2] = kfrag(kp, j + 2); if (j & 1) T1 = MFMA32(kf[j], qr[j >> 1], T1); else T0 = MFMA32(kf[j], qr[j >> 1], T0); }
        const int e = 4 * j;
        const float x0 = SEL32(S0, S1, e), x1 = SEL32(S0, S1, e + 1), x2 = SEL32(S0, S1, e + 2), x3 = SEL32(S0, S1, e + 3);
        sacc += x0; sacc += x1; sacc += x2; sacc += x3; PIN(sacc);
        const unsigned w0 = pk2(x0, x1), w1 = pk2(x2, x3);
        if (j & 1) { pw[j >> 1].z = w0; pw[j >> 1].w = w1; } else { pw[j >> 1].x = w0; pw[j >> 1].y = w1; }
        PIN(pw[j >> 1]);
        SBAR();
    }
    l += sacc;
}

__device__ __forceinline__ void attn_unit(int b, int h, int qb, const bf16* Q, const bf16* K, const bf16* V, bf16* CAT, const float* subln, float lam, LAS unsigned char* lds) {
    const int tid = opaque_tid(), lane = tid & 63, r32 = lane & 31, hi = lane >> 5; const int wid = __builtin_amdgcn_readfirstlane(tid >> 6);
    const int comp = wid >> 2, wq = wid & 3;
    const size_t rowbase = (size_t)b * SEQ; const int q0 = qb * 128; const int NT = (q0 + 128) / 64;
    const unsigned lds0 = (unsigned)(size_t)lds;
    LAS float* wsf = (LAS float*)(lds + WSF) + wid * 64;
    const bf16* Qw = Q + (rowbase + q0 + wq * 32 + r32) * 512 + h * 128 + comp * 64;
    bf16x8 qr[4];
#pragma unroll
    for (int d0 = 0; d0 < 4; ++d0) qr[d0] = *(const bf16x8*)(Qw + d0 * 16 + hi * 8);
    const bf16* ksrc[2]; const bf16* vsrc[2]; unsigned kdst[2], vdst[2];
#pragma unroll
    for (int i = 0; i < 2; ++i) { const int p = 2 * wid + i; const int kc = p >> 3, ch = p & 7, db = p >> 2, rg = p & 3;
        ksrc[i] = K + (rowbase + lane) * 512 + h * 128 + kc * 64 + ch * 8; kdst[i] = lds0 + KBUF + kc * 8192 + ch * 1024;
        vsrc[i] = V + (rowbase + 16 * rg + (lane >> 2)) * 512 + h * 128 + db * 32 + (lane & 3) * 8; vdst[i] = lds0 + VBUF + db * 4096 + rg * 1024; }
#define DMA_K(t) do { const unsigned so_ = (unsigned)(((t) % 3) * SLOT); _Pragma("unroll") for (int i_ = 0; i_ < 2; ++i_) glds16(ksrc[i_] + (size_t)(t) * 64 * 512, (unsigned)__builtin_amdgcn_readfirstlane(kdst[i_] + so_)); } while (0)
#define DMA_V(t) do { const unsigned so_ = (unsigned)(((t) % 3) * SLOT); _Pragma("unroll") for (int i_ = 0; i_ < 2; ++i_) glds16(vsrc[i_] + (size_t)(t) * 64 * 512, (unsigned)__builtin_amdgcn_readfirstlane(vdst[i_] + so_)); } while (0)
    f32x16 o[4];
#pragma unroll
    for (int d0 = 0; d0 < 4; ++d0) o[d0] = f32x16{};
    float mref = -INFINITY, l = 0.f, alpha = 1.f; bool resc = false;
    const int qrel = wq * 32 + r32;
    u32x4 pw[4];
#pragma unroll
    for (int k = 0; k < 4; ++k) pw[k] = (u32x4){0u, 0u, 0u, 0u};
    LAS const unsigned char* kbase = lds + KBUF + comp * 8192 + hi * 1024 + r32 * 16;
    LAS const unsigned char* vbase = lds + VBUF + ((lane >> 4) & 1) * 32 + (lane & 3) * 8 + (4 * hi + ((lane & 15) >> 2)) * 64;
    asm volatile("s_waitcnt vmcnt(0)" ::: "memory");
    DMA_K(0); DMA_V(0); DMA_K(1);
    { const int t2 = (2 < NT) ? 2 : NT - 1; _Pragma("unroll") for (int i_ = 0; i_ < 2; ++i_) glds16(ksrc[i_] + (size_t)t2 * 64 * 512, (unsigned)__builtin_amdgcn_readfirstlane(kdst[i_] + 2 * SLOT)); }
    asm volatile("s_waitcnt vmcnt(6)" ::: "memory");
    __builtin_amdgcn_s_barrier(); asm volatile("" ::: "memory");
    f32x16 SA = f32x16{}, SB = f32x16{}, TA, TB;
#pragma unroll
    for (int j = 0; j < 8; ++j) { const bf16x8 kf = kfrag(kbase, j); if (j & 1) SB = MFMA32(kf, qr[j >> 1], SB); else SA = MFMA32(kf, qr[j >> 1], SA); }
    asm volatile("s_waitcnt vmcnt(2) lgkmcnt(0)" ::: "memory");
    __builtin_amdgcn_s_barrier(); asm volatile("" ::: "memory");
#define ITER(DP, DQ, BD, S0_, S1_, T0_, T1_, t_, jb_) do { const int tt_ = (t_); \
        const int tk_ = (tt_ + 3 < NT) ? tt_ + 3 : NT - 1, tv_ = (tt_ + 1 < NT) ? tt_ + 1 : NT - 1;        \
        int ko_ = ((tt_ + 1) % 3) * SLOT, vo_ = ((tt_ + 2) % 3) * SLOT, kso_ = (tt_ % 3) * SLOT; asm volatile("" : "+s"(ko_), "+s"(vo_), "+s"(kso_));     \
        step<DP, DQ, BD>(S0_, S1_, T0_, T1_, o, pw, qr, mref, l, alpha, resc, kbase + ko_, vbase + vo_, (jb_), qrel, hi, \
            ksrc[0] + (size_t)tk_ * 64 * 512, ksrc[1] + (size_t)tk_ * 64 * 512, vsrc[0] + (size_t)tv_ * 64 * 512, vsrc[1] + (size_t)tv_ * 64 * 512, \
            (unsigned)__builtin_amdgcn_readfirstlane(kdst[0] + kso_), (unsigned)__builtin_amdgcn_readfirstlane(kdst[1] + kso_), \
            (unsigned)__builtin_amdgcn_readfirstlane(vdst[0] + ko_), (unsigned)__builtin_amdgcn_readfirstlane(vdst[1] + ko_)); \
        asm volatile("s_waitcnt vmcnt(4) lgkmcnt(0)" ::: "memory"); \
        __builtin_amdgcn_s_barrier(); asm volatile("" ::: "memory"); \
        if (resc) { if (hi == 0) wsf[r32] = alpha; LDS_WAIT(); \
            _Pragma("unroll") for (int r = 0; r < 16; ++r) { const float f_ = wsf[crow(r, hi)]; _Pragma("unroll") for (int d0 = 0; d0 < 4; ++d0) o[d0][r] *= f_; } } \
    } while (0)
    if (NT == 2) {
        ITER(false, true, true, SA, SB, TA, TB, 0, 0);
        ITER(true, false, true, TA, TB, SA, SB, 1, 1);
    } else {
        ITER(false, true, false, SA, SB, TA, TB, 0, 0);
        ITER(true, true, false, TA, TB, SA, SB, 1, 0);
        for (int t = 2; t < NT - 2; t += 2) {
            ITER(true, true, false, SA, SB, TA, TB, t, 0);
            ITER(true, true, false, TA, TB, SA, SB, t + 1, 0);
        }
        ITER(true, true, true, SA, SB, TA, TB, NT - 2, 0);
        ITER(true, false, true, TA, TB, SA, SB, NT - 1, 1);
    }
#undef ITER
    {
        int vo_ = ((NT - 1) % 3) * SLOT; asm volatile("" : "+s"(vo_));
        LAS const unsigned char* vp = vbase + vo_;
#pragma unroll
        for (int i = 0; i < 16; ++i) o[i & 3] = MFMA32(__builtin_bit_cast(bf16x8, pw[i >> 2]), vfrag(vp, i), o[i & 3]);
    }
    asm volatile("s_waitcnt vmcnt(0) lgkmcnt(0)" ::: "memory");
    __builtin_amdgcn_s_barrier(); asm volatile("" ::: "memory");
#undef DMA_K
#undef DMA_V
    const int tid2 = opaque_tid(), lane2 = tid2 & 63, r32b = lane2 & 31, hib = lane2 >> 5;
    LAS float* wsf2 = (LAS float*)(lds + WSF) + __builtin_amdgcn_readfirstlane(tid2 >> 6) * 64;
    { auto rr = __builtin_amdgcn_permlane32_swap(__float_as_uint(l), __float_as_uint(l), false, false); l = __uint_as_float(rr[0]) + __uint_as_float(rr[1]); }
    if (hib == 0) wsf2[r32b] = 1.0f / l;
    LDS_WAIT();
    float rli[16];
#pragma unroll
    for (int r = 0; r < 16; ++r) rli[r] = wsf2[crow(r, hib)];
    LAS float* X = (LAS float*)(lds + XOFF);
    if (comp == 1) {
#pragma unroll
        for (int d0 = 0; d0 < 4; ++d0)
#pragma unroll
            for (int r = 0; r < 16; ++r) X[((wq * 4 + d0) * 16 + r) * 64 + lane2] = lam * o[d0][r] * rli[r];
    }
    LDS_WAIT();
    __builtin_amdgcn_s_barrier(); asm volatile("" ::: "memory");
    if (comp == 0) {
        float ssq[16];
#pragma unroll
        for (int r = 0; r < 16; ++r) ssq[r] = 0.f;
#pragma unroll
        for (int d0 = 0; d0 < 4; ++d0)
#pragma unroll
            for (int r = 0; r < 16; ++r) { const float v = o[d0][r] * rli[r] - X[((wq * 4 + d0) * 16 + r) * 64 + lane2]; o[d0][r] = v; ssq[r] += v * v; }
#pragma unroll
        for (int r = 0; r < 16; ++r) {
            float s = ssq[r];
            s += __shfl_xor(s, 1); s += __shfl_xor(s, 2); s += __shfl_xor(s, 4); s += __shfl_xor(s, 8); s += __shfl_xor(s, 16);
            ssq[r] = 0.8f / sqrtf(s * (1.0f / 128.0f) + 1e-5f);
        }
        bf16* Ow = CAT + (rowbase + q0 + wq * 32) * 1024 + 512 + h * 128 + r32b;
#pragma unroll
        for (int d0 = 0; d0 < 4; ++d0) { const float gsub = subln[d0 * 32 + r32b];
#pragma unroll
            for (int r = 0; r < 16; ++r) { const float y = o[d0][r] * ssq[r] * gsub; Ow[(size_t)crow(r, hib) * 1024 + d0 * 32] = (bf16)(pk2(y, 0.f) & 0xffffu); } }
    }
    LDS_WAIT();
    __builtin_amdgcn_s_barrier(); asm volatile("" ::: "memory");
}
}

__device__ __forceinline__ void conv_phase(LAS unsigned char* lds, const bf16* Gt, bf16* Y, const float* dw_w, const float* dw_b, const float* ln_g, const float* ln_b, int vcu, int G) {
    const int tid = opaque_tid(), lane = tid & 63; const int wid = tid >> 6;
    const int c0 = 2 * tid;
    LAS float* red = (LAS float*)(lds + 62 * 2048);
    LAS float* mr = (LAS float*)(lds + 62 * 2048 + 2048);
    const f32x2 bia = *(const f32x2*)(dw_b + c0), gam = *(const f32x2*)(ln_g + c0), bet = *(const f32x2*)(ln_b + c0);
    for (int tile = vcu; tile < 1024; tile += G) {
        const int b = tile >> 8, t0 = (tile & 255) * 32;
        const float* dww = dw_w; asm volatile("" : "+s"(dww));
#pragma unroll 4
        for (int p = tid; p < 62 * 128; p += NWAVES * 64) {
            const int rr = p >> 7, pc = p & 127; const int t = t0 - 30 + rr; u32x4 v = {0u, 0u, 0u, 0u};
            if (t >= 0) v = *(const u32x4*)(Gt + ((size_t)b * SEQ + t) * 1024 + pc * 8);
            *(LAS u32x4*)(lds + rr * 2048 + pc * 16) = v;
        }
        __syncthreads();
        f32x2 av[32];
#pragma unroll
        for (int tt = 0; tt < 32; ++tt) av[tt] = bia;
#pragma unroll
        for (int half = 0; half < 2; ++half) {
            const int j0 = half * 16, nj = half ? 15 : 16;
            f32x2 wv[16];
#pragma unroll
            for (int j = 0; j < 16; ++j) { if (j < nj) wv[j] = *(const f32x2*)(dww + (j0 + j) * 1024 + c0); else wv[j] = (f32x2){0.f, 0.f}; }
#pragma unroll
            for (int th = 0; th < 2; ++th) {
#pragma unroll
                for (int q = 0; q < 31; ++q) {
                    const int rr = 16 * th + j0 + q;
                    const unsigned v = *(LAS const unsigned*)(lds + rr * 2048 + tid * 4); const f32x2 x = {bflo(v), bfhi(v)};
#pragma unroll
                    for (int i = 0; i < 16; ++i) { const int j = q - i; if (j >= 0 && j < nj) av[16 * th + i] += wv[j] * x; }
                }
                asm volatile("" ::: "memory");
            }
        }
        float a0[32], a1[32];
#pragma unroll
        for (int tt = 0; tt < 32; ++tt) { a0[tt] = av[tt][0]; a1[tt] = av[tt][1]; }
        float st[32];
        { const bool bit = (lane & 32) != 0;
#pragma unroll
          for (int i = 0; i < 32; ++i) { const float s1 = a0[i] + a1[i], s2 = a0[i] * a0[i] + a1[i] * a1[i]; const float keep = bit ? s2 : s1, send = bit ? s1 : s2; st[i] = keep + __shfl_xor(send, 32); } }
#define TR_STEP(N) { const bool bit = (lane & N) != 0; _Pragma("unroll") for (int i = 0; i < N; ++i) { const float keep = bit ? st[i + N] : st[i], send = bit ? st[i] : st[i + N]; st[i] = keep + __shfl_xor(send, N); } }
        TR_STEP(16) TR_STEP(8) TR_STEP(4) TR_STEP(2) TR_STEP(1)
#undef TR_STEP
        red[wid * 64 + lane] = st[0];
        __syncthreads();
        if (tid < 32) {
            float s1 = 0.f, s2 = 0.f;
#pragma unroll
            for (int w = 0; w < 8; ++w) { s1 += red[w * 64 + tid]; s2 += red[w * 64 + 32 + tid]; }
            const float mean = s1 * (1.0f / 1024.0f); const float var = fmaxf(s2 * (1.0f / 1024.0f) - mean * mean, 0.f);
            mr[2 * tid] = mean; mr[2 * tid + 1] = 1.0f / sqrtf(var + 1e-5f);
        }
        __syncthreads();
#pragma unroll
        for (int tt = 0; tt < 32; ++tt) {
            const float mean = mr[2 * tt], rstd = mr[2 * tt + 1];
            float y0 = (a0[tt] - mean) * rstd * gam[0] + bet[0], y1 = (a1[tt] - mean) * rstd * gam[1] + bet[1];
            y0 = y0 * __builtin_amdgcn_rcpf(1.0f + __builtin_amdgcn_exp2f(-1.4426950408889634f * y0));
            y1 = y1 * __builtin_amdgcn_rcpf(1.0f + __builtin_amdgcn_exp2f(-1.4426950408889634f * y1));
            *(LAS unsigned*)(lds + tt * 2048 + tid * 4) = pk2(y0, y1);
        }
        __syncthreads();
        {
            bf16* yb = Y + ((size_t)b * SEQ + t0) * 1024;
#pragma unroll 2
            for (int p = tid; p < 32 * 128; p += NWAVES * 64) { const int rr = p >> 7, pc = p & 127; *(u32x4*)(yb + (size_t)rr * 1024 + pc * 8) = *(LAS const u32x4*)(lds + rr * 2048 + pc * 16); }
        }
        __syncthreads();
    }
    __syncthreads();
}


__device__ __forceinline__ void final_phase(float* H, const float* ssp, const float* gfin, int vcu, int G, int wave, int lane) {
    const int gw = vcu * NWAVES + wave, NGW = G * NWAVES;
    f32x4 gv[4];
#pragma unroll
    for (int j = 0; j < 4; ++j) gv[j] = ((const f32x4*)gfin)[lane + 64 * j];
    for (int m = gw; m < M; m += NGW) {
        const float inv = pg8::row_inv_rms(ssp, m);
        f32x4* xr = (f32x4*)(H + (size_t)m * DM) + lane;
#pragma unroll
        for (int j = 0; j < 4; ++j) { f32x4 v = xr[64 * j]; v = v * inv * gv[j]; xr[64 * j] = v; }
    }
}

#define GAS __attribute__((address_space(1)))
#define XB_TMO      128
#define XB_XCNT(j)  (256  + 64 * (j))
#define XB_XSUB(j)  (1280 + 64 * (j))
#define XB_XGEN(j)  (2304 + 64 * (j))
#define XB_TOP      3328
#define XB_TOPGEN   3392
#define XCD_BAR_WORDS 3456
#define XB_SPIN_CAP (1u << 18)

__device__ __forceinline__ unsigned xb_ld(unsigned* p)              { return __hip_atomic_load(p, __ATOMIC_RELAXED, __HIP_MEMORY_SCOPE_AGENT); }
__device__ __forceinline__ unsigned xb_add(unsigned* p, unsigned v) { return __hip_atomic_fetch_add(p, v, __ATOMIC_RELAXED, __HIP_MEMORY_SCOPE_AGENT); }
__device__ __forceinline__ unsigned xb_xcc_id() { return (unsigned)__builtin_amdgcn_s_getreg((3 << 11) | 20) & 0xFu; }
#define XB_SPIN(cond, bar) do { unsigned _sp = 0; while (cond) { __builtin_amdgcn_s_sleep(1); \
    if ((++_sp & 255u) == 0u) { if (xb_ld(&(bar)[XB_TMO])) break; if (_sp > XB_SPIN_CAP) { atomicAdd(&(bar)[XB_TMO], 1u); break; } } } } while (0)

struct XcdBarrier {
    unsigned* bar; unsigned x;
    volatile LAS unsigned* st;
};

__device__ __forceinline__ XcdBarrier xcd_barrier_post(unsigned* bar, volatile LAS unsigned* st) {
    XcdBarrier b; b.bar = bar; b.x = xb_xcc_id(); b.st = st;
    if (threadIdx.x == 0) (void)xb_add(&bar[XB_XCNT(b.x)], 1u);
    return b;
}
__device__ __forceinline__ void xcd_barrier_complete(unsigned* bar, unsigned x, unsigned& nloc, unsigned& nx) {
    const unsigned G = gridDim.x * gridDim.y * gridDim.z;
    unsigned sum, cnt, mine, sp = 0u;
    for (;;) {
        sum = 0u; cnt = 0u; mine = 0u;
#pragma unroll
        for (unsigned j = 0; j < 16; ++j) { const unsigned c = xb_ld(&bar[XB_XCNT(j)]); sum += c; cnt += (c > 0u) ? 1u : 0u; mine = (j == x) ? c : mine; }
        if (sum == G) break;
        __builtin_amdgcn_s_sleep(1);
        if ((++sp & 255u) == 0u) { if (xb_ld(&bar[XB_TMO])) break; if (sp > XB_SPIN_CAP) { atomicAdd(&bar[XB_TMO], 1u); break; } }
    }
    nloc = mine > 0u ? mine : 1u; nx = cnt > 0u ? cnt : 1u;
}

__device__ __forceinline__ void xcd_barrier(const XcdBarrier& b) {
    asm volatile("s_waitcnt vmcnt(0)" ::: "memory");
    __syncthreads();
    if (threadIdx.x == 0) {
        unsigned* bar = b.bar;
        __builtin_amdgcn_s_waitcnt(0);
        unsigned nloc = b.st[0], nx = b.st[1];
        if (nloc == 0u) { xcd_barrier_complete(bar, b.x, nloc, nx); b.st[0] = nloc; b.st[1] = nx; }
        const unsigned old = xb_add(&bar[XB_XSUB(b.x)], 1u);
        const unsigned gen = old / nloc;
        if (old + 1u == (gen + 1u) * nloc) {
            __builtin_amdgcn_fence(__ATOMIC_RELEASE, "agent");
            asm volatile("s_waitcnt vmcnt(0)" ::: "memory");
            const unsigned og = xb_add(&bar[XB_TOP], 1u);
            const unsigned tg = og / nx;
            if (og + 1u == (tg + 1u) * nx) xb_add(&bar[XB_TOPGEN], 1u);
            else XB_SPIN(xb_ld(&bar[XB_TOPGEN]) == tg, bar);
            __builtin_amdgcn_fence(__ATOMIC_ACQUIRE, "agent");
            xb_add(&bar[XB_XGEN(b.x)], 1u);
            asm volatile("s_waitcnt vmcnt(0)" ::: "memory");
        } else {
            XB_SPIN(xb_ld(&bar[XB_XGEN(b.x)]) == gen, bar);
            __builtin_amdgcn_fence(__ATOMIC_ACQUIRE, "agent");
            asm volatile("s_waitcnt vmcnt(0)" ::: "memory");
        }
    }
    __syncthreads();
}

#ifndef PHASE_MASK
#define PHASE_MASK 0xfff
#endif
#define PH(k) ((PHASE_MASK >> (k)) & 1)
#ifndef PROBE_REPEAT
#define PROBE_REPEAT -1
#endif
#define REP(k) for (int rep_ = 0; rep_ < ((k) == PROBE_REPEAT ? 2 : 1); ++rep_)
__global__ void __launch_bounds__(NWAVES * 64, 2) fwd_megakernel(Args args) {
    extern __shared__ __attribute__((aligned(16))) unsigned char lds_raw[];
    LAS unsigned char* lds = (LAS unsigned char*)lds_raw;
    cg::grid_group grid = cg::this_grid();
    const int tid = threadIdx.x, lane = tid & 63; const int wave = __builtin_amdgcn_readfirstlane(tid >> 6);
    const int G = gridDim.x; const int bx = blockIdx.x; const int vcu = (G % 8 == 0) ? (bx % 8) * (G / 8) + bx / 8 : bx;
    unsigned char* ws = args.ws;
#define WSP(T, off) ((T*)(ws + (off)))
    float* H = args.out;
    unsigned* barw = (unsigned*)(ws + WS_CTL);
    volatile LAS unsigned* bst = (volatile LAS unsigned*)(lds + MISC_OFF);
    if (threadIdx.x < 2) bst[threadIdx.x] = 0u;
    __syncthreads();
    if (args.use_cg) grid.sync();
    const XcdBarrier xbar = xcd_barrier_post(barw, bst);
    REP(0) if (PH(0)) { const int t_ = opaque_tid(); prologue(args, lds, vcu, G, __builtin_amdgcn_readfirstlane(t_ >> 6), t_ & 63); }
    xcd_barrier(xbar);
    REP(1) if (PH(1)) { pg8::Gemm g{WSP(bf16, WS_AB), WSP(bf16, WS_WIN), M, INW, DM}; pg8::StaticOrder S; S.init(M, INW, G, bx); pg8::EpiIn E{WSP(bf16, WS_Z), WSP(float, WS_ROPE)};
      pg8::gemm_phase<pg8::EpiIn, pg8::StaticOrder, true, true>(lds, g, S, E); }
    xcd_barrier(xbar);
    REP(2) if (PH(2)) {
        bf16* Z = WSP(bf16, WS_Z); bf16* CAT = WSP(bf16, WS_CAT);
        pool_phase(Z, CAT, vcu, G, opaque_tid());
        float sa = args.in[9][lane] * args.in[10][lane], sb = args.in[11][lane] * args.in[12][lane];
        sa = wave_sum(sa); sb = wave_sum(sb);
        const float lam = __builtin_amdgcn_exp2f(sa * 1.4426950408889634f) - __builtin_amdgcn_exp2f(sb * 1.4426950408889634f) + 0.2f;
        const bf16* Qp = Z + (size_t)M * 512; const bf16* Kp = Z + (size_t)2 * M * 512; const bf16* Vp = Z + (size_t)3 * M * 512;
        for (int u = vcu; u < 16 * 16; u += G) {
            const int bh = u >> 4, s = u & 15;
#pragma unroll 1
            for (int i = 0; i < 4; ++i) { const int qb = (i == 0) ? s : (i == 1) ? 31 - s : (i == 2) ? 32 + s : 63 - s;
                att::attn_unit(bh >> 2, bh & 3, qb, Qp, Kp, Vp, CAT, args.in[13], lam, lds); }
        }
    }
    xcd_barrier(xbar);
    REP(3) if (PH(3)) { pg8::Gemm g{WSP(bf16, WS_CAT), WSP(bf16, WS_WCAT), M, DM, DM}; pg8::StaticOrder S; S.init(M, DM, G, bx); typedef pg8::EpiRes<false, false> EpiT; EpiT E{args.in[0], nullptr, nullptr, WSP(bf16, WS_AB), nullptr, WSP(float, WS_SSP)};
      pg8::gemm_phase<EpiT, pg8::StaticOrder, true, true>(lds, g, S, E); }
    xcd_barrier(xbar);
    REP(4) if (PH(4)) { pg8::Gemm g{WSP(bf16, WS_AB), WSP(bf16, WS_WUP), M, DFF, DM}; pg8::StaticOrder S; S.init(M, DFF, G, bx); pg8::EpiUp E{WSP(bf16, WS_HID), WSP(float, WS_SSP)};
      pg8::gemm_phase<pg8::EpiUp, pg8::StaticOrder, true, true>(lds, g, S, E); }
    xcd_barrier(xbar);
    REP(5) if (PH(5)) { pg8::Gemm g{WSP(bf16, WS_HID), WSP(bf16, WS_WDN), M, DM, DFF}; pg8::StaticOrder S; S.init(M, DM, G, bx); typedef pg8::EpiRes<true, false> EpiT; EpiT E{nullptr, WSP(bf16, WS_AB), nullptr, WSP(bf16, WS_AB), nullptr, WSP(float, WS_SSP)};
      pg8::gemm_phase<EpiT, pg8::StaticOrder, true, true>(lds, g, S, E); }
    xcd_barrier(xbar);
    REP(6) if (PH(6)) { pg8::Gemm g{WSP(bf16, WS_AB), WSP(bf16, WS_PW1), M, INW, DM}; pg8::StaticOrder S; S.init(M, INW, G, bx); pg8::EpiGlu E{WSP(bf16, WS_G), WSP(float, WS_SSP), args.in[16]};
      pg8::gemm_phase<pg8::EpiGlu, pg8::StaticOrder, true, true>(lds, g, S, E); }
    xcd_barrier(xbar);
    REP(7) if (PH(7)) conv_phase(lds, WSP(bf16, WS_G), WSP(bf16, WS_Y), args.in[17], args.in[18], args.in[19], args.in[20], vcu, G);
    xcd_barrier(xbar);
    REP(8) if (PH(8)) { pg8::Gemm g{WSP(bf16, WS_Y), WSP(bf16, WS_PW2), M, DM, DM}; pg8::StaticOrder S; S.init(M, DM, G, bx); typedef pg8::EpiRes<true, false> EpiT; EpiT E{nullptr, WSP(bf16, WS_AB), nullptr, WSP(bf16, WS_AB), args.in[22], WSP(float, WS_SSP)};
      pg8::gemm_phase<EpiT, pg8::StaticOrder, true, true>(lds, g, S, E); }
    xcd_barrier(xbar);
    REP(9) if (PH(9)) { pg8::Gemm g{WSP(bf16, WS_AB), WSP(bf16, WS_WUP) + (size_t)DFF * DM, M, DFF, DM}; pg8::StaticOrder S; S.init(M, DFF, G, bx); pg8::EpiUp E{WSP(bf16, WS_HID), WSP(float, WS_SSP)};
      pg8::gemm_phase<pg8::EpiUp, pg8::StaticOrder, true, true>(lds, g, S, E); }
    xcd_barrier(xbar);
    REP(10) if (PH(10)) { pg8::Gemm g{WSP(bf16, WS_HID), WSP(bf16, WS_WDN) + (size_t)DM * DFF, M, DM, DFF}; pg8::StaticOrder S; S.init(M, DM, G, bx); typedef pg8::EpiRes<true, true> EpiT; EpiT E{nullptr, WSP(bf16, WS_AB), H, nullptr, nullptr, WSP(float, WS_SSP)};
      pg8::gemm_phase<EpiT, pg8::StaticOrder, true, true>(lds, g, S, E); }
    xcd_barrier(xbar);
    if (PH(11)) { const int t_ = opaque_tid(); final_phase(H, WSP(float, WS_SSP), args.in[5], vcu, G, __builtin_amdgcn_readfirstlane(t_ >> 6), t_ & 63); }
}

extern "C" void kernel_launch(void* const* d_in, const int* in_sizes, int n_in, void* d_out, int out_size, void* d_ws, size_t ws_size, hipStream_t stream) {
    static int grid = 0;
    if (grid == 0) {
        if (n_in != 23 || in_sizes[0] != M * DM || out_size != M * DM || ws_size < WS_END) { fprintf(stderr, "kernel_launch: unexpected shapes (n_in %d, in0 %d, out %d, ws %zu)\n", n_in, n_in > 0 ? in_sizes[0] : -1, out_size, ws_size); grid = -1; return; }
        int dev = 0, cus = 0, per_cu = 0;
        if (hipGetDevice(&dev) != hipSuccess || hipDeviceGetAttribute(&cus, hipDeviceAttributeMultiprocessorCount, dev) != hipSuccess) { grid = -1; return; }
        if (hipFuncSetAttribute((const void*)fwd_megakernel, hipFuncAttributeMaxDynamicSharedMemorySize, LDS_BYTES) != hipSuccess) { fprintf(stderr, "kernel_launch: hipFuncSetAttribute failed\n"); grid = -1; return; }
        if (hipOccupancyMaxActiveBlocksPerMultiprocessor(&per_cu, (const void*)fwd_megakernel, NWAVES * 64, LDS_BYTES) != hipSuccess || per_cu < 1) { fprintf(stderr, "kernel_launch: occupancy query says %d\n", per_cu); per_cu = 1; }
        (void)hipGetLastError();
        grid = cus * 1;
        fprintf(stderr, "kernel_launch: grid %d (cus %d, occupancy %d)\n", grid, cus, per_cu);
    }
    if (grid < 0) return;
    if (hipMemsetAsync((char*)d_ws + WS_CTL, 0, 16384, stream) != hipSuccess) { fprintf(stderr, "kernel_launch: hipMemsetAsync failed\n"); return; }
    Args a{};
    for (int i = 0; i < 23; ++i) a.in[i] = (const float*)d_in[i];
    a.out = (float*)d_out; a.ws = (unsigned char*)d_ws;
    for (int i = 0; i < 8; ++i) a.invf[i] = (float)std::pow(500000.0, -(double)i / 8.0);
    void* kargs[] = {&a};
    hipError_t e = hipLaunchCooperativeKernel((const void*)fwd_megakernel, dim3(grid), dim3(NWAVES * 64), kargs, LDS_BYTES, stream);
    if (e != hipSuccess) fprintf(stderr, "kernel_launch: cooperative launch failed: %s (grid %d)\n", hipGetErrorString(e), grid);
}
```
